# Optimizing an MI355X kernel written in HIP

```python
import math
import jax, jax.numpy as jnp
from jax import lax
import numpy as np

D_MODEL = 2048
BATCH = 8
SEQ = 2048
DEPTH = 4

D_MIX = D_MODEL
MLA_HEADS = 8
MLA_NOPE = 128
MLA_ROPE = 64
MLA_V = 128
KV_RANK = 512
RET_HEADS = 4
RET_DK = 128
RET_DV = 128
HG_HEADS = 4
HG_DK = 128
HG_DV = 128
D_FF = 5632
Q_BLOCK = 128
RET_CHUNK = 128
HG_CHUNK = 64
ROPE_BASE = 10000.0
EPS = 1e-6
MASK_VALUE = -1e30
MIN_FORGET = 1e-20

MLA_OUT = MLA_HEADS * MLA_V
RET_OUT = RET_HEADS * RET_DV
HG_OUT = HG_HEADS * HG_DV
IN_SPLITS = (MLA_HEADS * (MLA_NOPE + MLA_ROPE), KV_RANK, MLA_ROPE,
             RET_HEADS * RET_DK, RET_HEADS * RET_DK, RET_OUT, RET_OUT,
             HG_HEADS * HG_DK, HG_HEADS * HG_DK, HG_OUT, HG_OUT)
D_IN = sum(IN_SPLITS)

kernel_name = "hymba_mla_retnet_hgrn2_macaron"


def rms_norm(x, w):
    xf = x.astype(jnp.float32)
    y = xf * lax.rsqrt(jnp.mean(xf * xf, axis=-1, keepdims=True) + EPS)
    return y.astype(x.dtype) * w


def rope_tables(n, dim):
    inv = ROPE_BASE ** (-jnp.arange(0, dim, 2, dtype=jnp.float32) / dim)
    ang = jnp.arange(n, dtype=jnp.float32)[:, None] * inv[None, :]
    return jnp.cos(ang), jnp.sin(ang)


def apply_rope(x, cos, sin):
    shape = (1, cos.shape[0]) + (1,) * (x.ndim - 3) + (cos.shape[1],)
    c = cos.reshape(shape).astype(x.dtype)
    s = sin.reshape(shape).astype(x.dtype)
    x1, x2 = jnp.split(x, 2, axis=-1)
    return jnp.concatenate([x1 * c - x2 * s, x2 * c + x1 * s], axis=-1)


def swiglu(x, w1, w3, w2):
    return (jax.nn.silu(x @ w1) * (x @ w3)) @ w2


def mla_attention(q_all, c_kv, k_rope, kv_norm_w, w_kv_b, out_norm_w, cos, sin):
    B, S, _ = q_all.shape
    q = q_all.reshape(B, S, MLA_HEADS, MLA_NOPE + MLA_ROPE)
    q_nope = q[..., :MLA_NOPE]
    q_rope = apply_rope(q[..., MLA_NOPE:], cos, sin)
    k_rope = apply_rope(k_rope, cos, sin)
    kv = (rms_norm(c_kv, kv_norm_w) @ w_kv_b).reshape(B, S, MLA_HEADS, MLA_NOPE + MLA_V)
    k_nope, v = kv[..., :MLA_NOPE], kv[..., MLA_NOPE:]
    scale = (MLA_NOPE + MLA_ROPE) ** -0.5
    outs = []
    for blk in range(S // Q_BLOCK):
        q0, q1 = blk * Q_BLOCK, (blk + 1) * Q_BLOCK
        s = (jnp.einsum('bqhd,bkhd->bhqk', q_nope[:, q0:q1], k_nope[:, :q1])
             + jnp.einsum('bqhr,bkr->bhqk', q_rope[:, q0:q1], k_rope[:, :q1]))
        s = s.astype(jnp.float32) * scale
        qpos = jnp.arange(q0, q1)
        kpos = jnp.arange(q1)
        s = jnp.where(kpos[None, :] <= qpos[:, None], s, MASK_VALUE)
        p = jax.nn.softmax(s, axis=-1).astype(v.dtype)
        outs.append(jnp.einsum('bhqk,bkhd->bqhd', p, v[:, :q1]))
    o = jnp.concatenate(outs, axis=1)
    o = rms_norm(o, out_norm_w.reshape(MLA_HEADS, MLA_V))
    return o.reshape(B, S, MLA_OUT)


def retention(q, k, v, g, gn_w, cos, sin):
    B, S, _ = q.shape
    dt = g.dtype
    q = apply_rope(q.reshape(B, S, RET_HEADS, RET_DK), cos, sin)
    k = apply_rope(k.reshape(B, S, RET_HEADS, RET_DK), cos, sin) * (RET_DK ** -0.5)
    v = v.reshape(B, S, RET_HEADS, RET_DV)
    log_gamma = jnp.log1p(-(2.0 ** (-5.0 - jnp.arange(RET_HEADS, dtype=jnp.float32))))
    idx = jnp.arange(RET_CHUNK, dtype=jnp.float32)
    rel = idx[:, None] - idx[None, :]
    decay = jnp.where(rel >= 0, jnp.exp(log_gamma[:, None, None] * jnp.maximum(rel, 0.0)), 0.0)
    xi = jnp.exp(log_gamma[None, :] * (idx[:, None] + 1.0))
    zeta = jnp.exp(log_gamma[:, None] * (RET_CHUNK - 1.0 - idx[None, :]))
    g_chunk = jnp.exp(log_gamma * RET_CHUNK)
    n = S // RET_CHUNK

    def to_chunks(t):
        return t.astype(jnp.float32).reshape(B, n, RET_CHUNK, RET_HEADS, -1).swapaxes(0, 1)

    def step(R, inp):
        qi, ki, vi = inp
        intra = jnp.einsum('bihd,bjhd->bhij', qi, ki) * decay[None]
        o = (jnp.einsum('bhij,bjhe->bihe', intra, vi)
             + jnp.einsum('bihd,bhde->bihe', qi, R) * xi[None, :, :, None])
        R = R * g_chunk[None, :, None, None] + jnp.einsum('bjhd,bjhe,hj->bhde', ki, vi, zeta)
        return R, o

    R0 = jnp.zeros((B, RET_HEADS, RET_DK, RET_DV), jnp.float32)
    _, o = lax.scan(step, R0, (to_chunks(q), to_chunks(k), to_chunks(v)))
    o = o.swapaxes(0, 1).reshape(B, S, RET_HEADS, RET_DV)
    mu = jnp.mean(o, axis=-1, keepdims=True)
    var = jnp.mean(jnp.square(o - mu), axis=-1, keepdims=True)
    o = ((o - mu) * lax.rsqrt(var + EPS)).astype(dt) * gn_w.reshape(RET_HEADS, RET_DV)
    return jax.nn.silu(g) * o.reshape(B, S, RET_OUT)


def hgrn2(q, f_logit, i_in, g, lb, norm_w):
    B, S, _ = q.shape
    dt = g.dtype
    shp = (B, S, HG_HEADS, HG_DK)
    q = q.reshape(shp).astype(jnp.float32)
    z = f_logit.reshape(shp).astype(jnp.float32)
    v = i_in.reshape(B, S, HG_HEADS, HG_DV).astype(jnp.float32)
    lb = lb.reshape(HG_HEADS, HG_DK).astype(jnp.float32)
    f = lb + (1.0 - lb) * jax.nn.sigmoid(z)
    log_f = jnp.log(jnp.maximum(f, MIN_FORGET))
    k = (1.0 - lb) * jax.nn.sigmoid(-z)
    n = S // HG_CHUNK
    causal = (jnp.arange(HG_CHUNK)[:, None] >= jnp.arange(HG_CHUNK)[None, :])[None, :, :, None, None]

    def to_chunks(t):
        return t.reshape(B, n, HG_CHUNK, HG_HEADS, -1).swapaxes(0, 1)

    def step(St, inp):
        qi, ki, vi, lfi = inp
        b = jnp.cumsum(lfi, axis=1)
        diff = b[:, :, None] - b[:, None, :]
        dec = jnp.where(causal, jnp.exp(jnp.where(causal, diff, 0.0)), 0.0)
        A = jnp.einsum('bihk,bjhk,bijhk->bhij', qi, ki, dec)
        o = (jnp.einsum('bhij,bjhv->bihv', A, vi)
             + jnp.einsum('bihk,bhkv->bihv', qi * jnp.exp(b), St))
        b_last = b[:, -1:]
        St = (jnp.exp(b_last[:, 0])[..., None] * St
              + jnp.einsum('bjhk,bjhv->bhkv', ki * jnp.exp(b_last - b), vi))
        return St, o

    S0 = jnp.zeros((B, HG_HEADS, HG_DK, HG_DV), jnp.float32)
    _, o = lax.scan(step, S0, (to_chunks(q), to_chunks(k), to_chunks(v), to_chunks(log_f)))
    o = o.swapaxes(0, 1).reshape(B, S, HG_HEADS, HG_DV)
    o = o * lax.rsqrt(jnp.mean(o * o, axis=-1, keepdims=True) + EPS)
    o = o.astype(dt) * norm_w.reshape(HG_HEADS, HG_DV)
    return jax.nn.silu(g) * o.reshape(B, S, HG_OUT)


def token_mixer(h, w_in, kv_norm_w, w_kv_b, mla_norm_w, ret_gn_w, lb, hg_norm_w, w_o, rope_mla, rope_ret):
    proj = h @ w_in
    cuts = [int(c) for c in np.cumsum(IN_SPLITS)[:-1]]
    (mq, ckv, krope, rq, rk, rv, rg, hq, hf, hi, hg) = jnp.split(proj, cuts, axis=-1)
    o_a = mla_attention(mq, ckv, krope, kv_norm_w, w_kv_b, mla_norm_w, *rope_mla)
    o_b = retention(rq, rk, rv, rg, ret_gn_w, *rope_ret)
    o_c = hgrn2(hq, hf, hi, hg, lb, hg_norm_w)
    return jnp.concatenate([o_a, o_b, o_c], axis=-1) @ w_o


def setup_inputs(seed: int = 0) -> dict:
    key = jax.random.key(seed)
    ks = jax.random.split(key, 20)
    nrm = lambda k, shape, fan: jax.random.normal(k, shape, jnp.float32) * (fan ** -0.5)
    gain = lambda k, shape: 1.0 + 0.02 * jax.random.normal(k, shape, jnp.float32)
    D = D_MODEL
    return {
        "x": jax.random.normal(ks[0], (BATCH, SEQ, D), jnp.float32),
        "ffn1_norm": gain(ks[1], (DEPTH, D)),
        "ffn1_w1": nrm(ks[2], (DEPTH, D, D_FF), D),
        "ffn1_w3": nrm(ks[3], (DEPTH, D, D_FF), D),
        "ffn1_w2": nrm(ks[4], (DEPTH, D_FF, D), D_FF),
        "mix_norm": gain(ks[5], (DEPTH, D)),
        "w_in": nrm(ks[6], (DEPTH, D, D_IN), D),
        "mla_kv_norm": gain(ks[7], (DEPTH, KV_RANK)),
        "mla_w_kv_b": nrm(ks[8], (DEPTH, KV_RANK, MLA_HEADS * (MLA_NOPE + MLA_V)), KV_RANK),
        "mla_out_norm": gain(ks[9], (DEPTH, MLA_OUT)),
        "ret_gn": gain(ks[10], (DEPTH, RET_OUT)),
        "hgrn_lb_logits": 0.5 * jax.random.normal(ks[11], (DEPTH, HG_HEADS * HG_DK), jnp.float32),
        "hgrn_out_norm": gain(ks[12], (DEPTH, HG_OUT)),
        "w_o": nrm(ks[13], (DEPTH, D_MIX, D), D_MIX),
        "ffn2_norm": gain(ks[14], (DEPTH, D)),
        "ffn2_w1": nrm(ks[15], (DEPTH, D, D_FF), D),
        "ffn2_w3": nrm(ks[16], (DEPTH, D, D_FF), D),
        "ffn2_w2": nrm(ks[17], (DEPTH, D_FF, D), D_FF),
        "final_norm": gain(ks[18], (D,)),
    }


def reference(x, ffn1_norm, ffn1_w1, ffn1_w3, ffn1_w2, mix_norm, w_in, mla_kv_norm, mla_w_kv_b,
              mla_out_norm, ret_gn, hgrn_lb_logits, hgrn_out_norm, w_o, ffn2_norm, ffn2_w1,
              ffn2_w3, ffn2_w2, final_norm):
    S = x.shape[1]
    rope_mla = rope_tables(S, MLA_ROPE)
    rope_ret = rope_tables(S, RET_DK)
    p = jax.nn.softmax(hgrn_lb_logits.astype(jnp.float32), axis=0)
    lbs = jnp.cumsum(p, axis=0) - p[0:1]
    h = x
    for l in range(DEPTH):
        h = h + 0.5 * swiglu(rms_norm(h, ffn1_norm[l]), ffn1_w1[l], ffn1_w3[l], ffn1_w2[l])
        h = h + token_mixer(rms_norm(h, mix_norm[l]), w_in[l], mla_kv_norm[l], mla_w_kv_b[l],
                            mla_out_norm[l], ret_gn[l], lbs[l], hgrn_out_norm[l], w_o[l],
                            rope_mla, rope_ret)
        h = h + 0.5 * swiglu(rms_norm(h, ffn2_norm[l]), ffn2_w1[l], ffn2_w3[l], ffn2_w2[l])
    return rms_norm(h, final_norm)
```

```cpp
#include <hip/hip_runtime.h>
#include <cstdio>
#include <cstdint>

#ifndef MK_ONE_LAUNCH
#define MK_ONE_LAUNCH 1
#endif

constexpr int BATCH = 8, SEQ = 2048, DM = 2048, DEPTH = 4, DFF = 5632, DIN = 6208, KVR = 512;
constexpr int M = BATCH * SEQ;
constexpr int NUP = 2 * DFF;
constexpr int NIN = 6400;
constexpr float EPS = 1e-6f;
constexpr float QSCALE = 0.10411755f;
constexpr float RKSCALE = 0.08838834764831845f;
constexpr float LOG2E = 1.4426950408889634f;

namespace pg8 {
#define PG8_LAS __attribute__((address_space(3)))
typedef unsigned short bf16_t;
typedef short bf16x8 __attribute__((ext_vector_type(8)));
typedef float f32x4 __attribute__((ext_vector_type(4)));
typedef unsigned u32x4 __attribute__((ext_vector_type(4)));
constexpr int BM = 256, BK = 64, HALF = 128, HTB = HALF * BK * 2  , STAGE_BYTES = 8 * HTB, NXCD = 8, WGM = 8;

__host__ __device__ __forceinline__ int lds_byte(int r, int c) { const int st = (r >> 4) * 2 + (c >> 5), rr = r & 15, cc = c & 31, ob = rr * 64 + cc * 2; return st * 1024 + (ob ^ (((ob >> 9) & 1) << 5)); }
__host__ __device__ __forceinline__ void stage_rc(int b, int& R, int& C) { const int st = b / 1024, sb = b % 1024, swz = sb ^ (((sb >> 9) & 1) << 5); R = (st >> 1) * 16 + swz / 64; C = (st & 1) * 32 + (swz % 64) / 2; }
__host__ __device__ __forceinline__ int perm32(int rho) { const int n = rho >> 4, i = rho & 15; return 8 * (i >> 2) + 4 * n + (i & 3); }

struct Unit { int pm, pn; };
struct Gemm { const bf16_t* A; const bf16_t* Bt; int M, N, K; };

struct StaticOrder {
    int nM, nN, nwg, G, c;
    __host__ __device__ void init(int M, int N, int G_, int c_) { nM = M / BM; nN = N / BM; nwg = nM * nN; G = G_; c = c_; }
    __host__ __device__ bool next(int i, Unit& u) const {
        const long L = (long)i * G + c; if (L >= nwg) return false;
        int wgid = (int)L; { const int q = nwg / NXCD, r = nwg % NXCD, xcd = wgid % NXCD, off = wgid / NXCD; wgid = (xcd < r ? xcd * (q + 1) : r * (q + 1) + (xcd - r) * q) + off; }
        const int nig = WGM * nN, gid = wgid / nig, fm = gid * WGM, gsz = (nM - fm) < WGM ? (nM - fm) : WGM;
        u.pm = fm + ((wgid % nig) % gsz); u.pn = (wgid % nig) / gsz; return true;
    }
    __device__ __forceinline__ void a_ready(const Unit&) const {}
    __device__ __forceinline__ void done(const Unit&) const {}
};

__device__ __forceinline__ unsigned cvt_pk_bf16(float lo, float hi) { unsigned r; asm volatile("v_cvt_pk_bf16_f32 %0, %1, %2" : "=v"(r) : "v"(lo), "v"(hi)); return r; }
typedef float f32x2 __attribute__((ext_vector_type(2)));

typedef unsigned u32x2 __attribute__((ext_vector_type(2)));
typedef unsigned long long ss_t;
__device__ __forceinline__ float ss_get(const ss_t* p) { return (float)(*p) * (1.f / 1048576.f); }
__device__ __forceinline__ void ss_add(ss_t* p, float part) { atomicAdd(p, (ss_t)(part * 1048576.f + 0.5f)); }
__device__ __forceinline__ float ex2(float x) { return __builtin_amdgcn_exp2f(x); }
__device__ __forceinline__ float rcpf_(float x) { return __builtin_amdgcn_rcpf(x); }
__device__ __forceinline__ float rsq(float x) { return __builtin_amdgcn_rsqf(x); }
__device__ __forceinline__ float siluf_(float x) { return x * rcpf_(1.f + ex2(-x * LOG2E)); }
__device__ __forceinline__ u32x4 pack8f(const float (&o)[8]) { u32x4 w; w.x = cvt_pk_bf16(o[0], o[1]); w.y = cvt_pk_bf16(o[2], o[3]); w.z = cvt_pk_bf16(o[4], o[5]); w.w = cvt_pk_bf16(o[6], o[7]); return w; }
__device__ __forceinline__ void rope8(float (&v)[8], const f32x4 c, const f32x4 s) {
#pragma unroll
    for (int q = 0; q < 4; ++q) { const float a = v[2 * q], b = v[2 * q + 1]; v[2 * q] = a * c[q] - b * s[q]; v[2 * q + 1] = b * c[q] + a * s[q]; }
}
#define AT(T, base, byteoff) ((T*)((char*)(base) + (unsigned)(byteoff)))
#define EPI_FENCE() do { asm volatile("" ::: "memory"); __builtin_amdgcn_sched_barrier(0); } while (0)
#define EPI_V8(v, ai, bj, m, sc) do { _Pragma("unroll") for (int n_ = 0; n_ < 2; ++n_) _Pragma("unroll") for (int j_ = 0; j_ < 4; ++j_) v[4 * n_ + j_] = acc[ai][bj][m][n_][j_] * (sc); } while (0)

struct EpiUp {
    static constexpr bool PERM = true, AFTER_DRAIN = false;
    bf16_t* G; const ss_t* ss;
    __device__ __forceinline__ void operator()(const f32x4 (&acc)[2][2][4][2], const Unit& u, int wr, int wc, int fr, int fq) const {
        asm volatile("" : "+v"(fr), "+v"(fq));
        const int row0 = u.pm * BM + wr * 64 + fr, col0 = u.pn * HALF + wc * 32 + 8 * fq;
#pragma unroll
        for (int ai = 0; ai < 2; ++ai)
#pragma unroll
            for (int m = 0; m < 4; ++m) { const int row = row0 + ai * HALF + m * 16; const float rs = rsq(ss_get(AT(const ss_t, ss, row * 8u)) * (1.f / DM) + EPS);
                float g[8], up[8], o[8]; EPI_V8(g, ai, 0, m, rs); EPI_V8(up, ai, 1, m, rs);
#pragma unroll
                for (int i = 0; i < 8; ++i) o[i] = siluf_(g[i]) * up[i];
                *AT(u32x4, G, (unsigned)row * (DFF * 2u) + col0 * 2u) = pack8f(o); EPI_FENCE(); }
    }
};

struct EpiRes {
    static constexpr bool PERM = true, AFTER_DRAIN = false;
    const float* src; float* dst; bf16_t* hb; ss_t* ssn; float alpha;
    __device__ __forceinline__ void operator()(const f32x4 (&acc)[2][2][4][2], const Unit& u, int wr, int wc, int fr, int fq) const {
        asm volatile("" : "+v"(fr), "+v"(fq));
        const int row0 = u.pm * BM + wr * 64 + fr, col0 = u.pn * BM + wc * 32 + 8 * fq;
#pragma unroll
        for (int ai = 0; ai < 2; ++ai)
#pragma unroll
            for (int m = 0; m < 4; ++m) { const int row = row0 + ai * HALF + m * 16; float part = 0.f;
#pragma unroll
                for (int bj = 0; bj < 2; ++bj) { const unsigned off = (unsigned)row * DM + col0 + bj * HALF;
                    const f32x4 a0 = *AT(const f32x4, src, off * 4u), a1 = *AT(const f32x4, src, off * 4u + 16u);
                    const f32x4 o0 = a0 + acc[ai][bj][m][0] * alpha, o1 = a1 + acc[ai][bj][m][1] * alpha;
                    *AT(f32x4, dst, off * 4u) = o0; *AT(f32x4, dst, off * 4u + 16u) = o1;
                    part += (o0[0] * o0[0] + o0[1] * o0[1]) + (o0[2] * o0[2] + o0[3] * o0[3]) + (o1[0] * o1[0] + o1[1] * o1[1]) + (o1[2] * o1[2] + o1[3] * o1[3]);
                    u32x4 w; w.x = cvt_pk_bf16(o0[0], o0[1]); w.y = cvt_pk_bf16(o0[2], o0[3]); w.z = cvt_pk_bf16(o1[0], o1[1]); w.w = cvt_pk_bf16(o1[2], o1[3]);
                    *AT(u32x4, hb, off * 2u) = w; }
                part += __shfl_xor(part, 16); part += __shfl_xor(part, 32);
                if (fq == 0) ss_add(AT(ss_t, ssn, row * 8u), part); EPI_FENCE(); }
    }
};

struct EpiIn {
    static constexpr bool PERM = true, AFTER_DRAIN = false;
    const ss_t* ss; ss_t* sskv; const float* tab; const float* lb;
    bf16_t *QB, *KB, *CKV, *XB; float* HLF;
    __device__ __forceinline__ void operator()(const f32x4 (&acc)[2][2][4][2], const Unit& u, int wr, int wc, int fr, int fq) const {
        asm volatile("" : "+v"(fr), "+v"(fq));
        const int row0 = u.pm * BM + wr * 64 + fr, pn = u.pn, cw = wc * 32 + 8 * fq;
        const float* cM = tab; const float* sM = tab + 65536; const float* cR = tab + 131072; const float* sR = tab + 262144;
        bf16_t* xb = XB + (size_t)((pn - 9) >> 1) * ((size_t)M * 512);
        float rs[2][4];
#pragma unroll
        for (int ai = 0; ai < 2; ++ai)
#pragma unroll
            for (int m = 0; m < 4; ++m) rs[ai][m] = rsq(ss_get(AT(const ss_t, ss, (row0 + ai * HALF + m * 16) * 8u)) * (1.f / DM) + EPS);
        if (pn < 4) {
#pragma unroll
            for (int ai = 0; ai < 2; ++ai)
#pragma unroll
                for (int m = 0; m < 4; ++m) { const int row = row0 + ai * HALF + m * 16;
#pragma unroll
                    for (int bj = 0; bj < 2; ++bj) { float v[8]; EPI_V8(v, ai, bj, m, rs[ai][m] * QSCALE);
                        *AT(u32x4, QB, (unsigned)row * 3072u + ((2 * pn + bj) * 192 + cw) * 2u) = pack8f(v); } EPI_FENCE(); }
        } else if (pn < 6) {
#pragma unroll
            for (int bj = 0; bj < 2; ++bj) { const int e0 = 256 * (pn - 4) + HALF * bj + cw, head = e0 >> 6, p0 = e0 & 63, i0 = p0 >> 1;
#pragma unroll
                for (int ai = 0; ai < 2; ++ai)
#pragma unroll
                    for (int m = 0; m < 4; ++m) { const int row = row0 + ai * HALF + m * 16, t = row & (SEQ - 1);
                        const f32x4 c4 = *AT(const f32x4, cM, (t * 32 + i0) * 4u), s4 = *AT(const f32x4, sM, (t * 32 + i0) * 4u);
                        float v[8]; EPI_V8(v, ai, bj, m, rs[ai][m] * QSCALE); rope8(v, c4, s4);
                        *AT(u32x4, QB, (unsigned)row * 3072u + (head * 192 + 128 + p0) * 2u) = pack8f(v); EPI_FENCE(); } }
        } else if (pn < 8) {
#pragma unroll
            for (int ai = 0; ai < 2; ++ai)
#pragma unroll
                for (int m = 0; m < 4; ++m) { const int row = row0 + ai * HALF + m * 16; float part = 0.f;
#pragma unroll
                    for (int bj = 0; bj < 2; ++bj) { float v[8]; EPI_V8(v, ai, bj, m, rs[ai][m]);
#pragma unroll
                        for (int i = 0; i < 8; ++i) part += v[i] * v[i];
                        *AT(u32x4, CKV, (unsigned)row * (KVR * 2u) + (256 * (pn - 6) + HALF * bj + cw) * 2u) = pack8f(v); }
                    part += __shfl_xor(part, 16); part += __shfl_xor(part, 32);
                    if (fq == 0) ss_add(AT(ss_t, sskv, row * 8u), part); EPI_FENCE(); }
        } else if (pn == 8) {
            if (wc < 2) { const int p0 = cw, i0 = p0 >> 1;
#pragma unroll
                for (int ai = 0; ai < 2; ++ai)
#pragma unroll
                    for (int m = 0; m < 4; ++m) { const int row = row0 + ai * HALF + m * 16, t = row & (SEQ - 1);
                        const f32x4 c4 = *AT(const f32x4, cM, (t * 32 + i0) * 4u), s4 = *AT(const f32x4, sM, (t * 32 + i0) * 4u);
                        float v[8]; EPI_V8(v, ai, 0, m, rs[ai][m]); rope8(v, c4, s4); const u32x4 w = pack8f(v);
#pragma unroll
                        for (int hd = 0; hd < 8; ++hd) *AT(u32x4, KB, (unsigned)row * 3072u + (hd * 192 + 128 + p0) * 2u) = w; EPI_FENCE(); } }
        } else if (pn < 13) {
            const bool isk = pn >= 11; bf16_t* dstb = xb; const float sc = isk ? RKSCALE : 1.f; const int pp = pn - (isk ? 11 : 9), i0 = cw >> 1;
#pragma unroll
            for (int bj = 0; bj < 2; ++bj)
#pragma unroll
                for (int ai = 0; ai < 2; ++ai)
#pragma unroll
                    for (int m = 0; m < 4; ++m) { const int row = row0 + ai * HALF + m * 16, t = row & (SEQ - 1);
                        const f32x4 c4 = *AT(const f32x4, cR, (t * 64 + i0) * 4u), s4 = *AT(const f32x4, sR, (t * 64 + i0) * 4u);
                        float v[8]; EPI_V8(v, ai, bj, m, rs[ai][m] * sc); rope8(v, c4, s4);
                        *AT(u32x4, dstb, (unsigned)row * 1024u + ((2 * pp + bj) * 128 + cw) * 2u) = pack8f(v); EPI_FENCE(); }
        } else if (pn == 19 || pn == 20) {
#pragma unroll
            for (int bj = 0; bj < 2; ++bj) { const int col = 256 * (pn - 19) + HALF * bj + cw;
                const f32x4 l0 = *AT(const f32x4, lb, col * 4u), l1 = *AT(const f32x4, lb, col * 4u + 16u); const float lbv[8] = {l0[0], l0[1], l0[2], l0[3], l1[0], l1[1], l1[2], l1[3]};
#pragma unroll
                for (int ai = 0; ai < 2; ++ai)
#pragma unroll
                    for (int m = 0; m < 4; ++m) { const int row = row0 + ai * HALF + m * 16; float z[8], lf[8], kk[8]; EPI_V8(z, ai, bj, m, rs[ai][m]);
#pragma unroll
                        for (int i = 0; i < 8; ++i) { const float zc = fminf(fmaxf(z[i], -60.f), 60.f), e = ex2(-zc * LOG2E), sig = rcpf_(1.f + e), nsig = e * sig, om = 1.f - lbv[i];
                            const float f = lbv[i] + om * sig; lf[i] = __builtin_amdgcn_logf(fmaxf(f, 1e-20f)) * 0.6931471805599453f; kk[i] = om * nsig; }
                        const unsigned lo_ = (unsigned)row * 2048u + col * 4u; *AT(f32x4, HLF, lo_) = (f32x4){lf[0], lf[1], lf[2], lf[3]}; *AT(f32x4, HLF, lo_ + 16u) = (f32x4){lf[4], lf[5], lf[6], lf[7]};
                        *AT(u32x4, xb, (unsigned)row * 1024u + col * 2u) = pack8f(kk); EPI_FENCE(); } }
        } else {
            bf16_t* dstb = xb; const bool act = (pn == 15 || pn == 16 || pn >= 23); const int cb = 256 * ((pn + 1) & 1);
#pragma unroll
            for (int ai = 0; ai < 2; ++ai)
#pragma unroll
                for (int m = 0; m < 4; ++m) { const int row = row0 + ai * HALF + m * 16;
#pragma unroll
                    for (int bj = 0; bj < 2; ++bj) { float v[8]; EPI_V8(v, ai, bj, m, rs[ai][m]);
                        if (act) {
#pragma unroll
                            for (int i = 0; i < 8; ++i) v[i] = siluf_(v[i]); }
                        *AT(u32x4, dstb, (unsigned)row * 1024u + (cb + HALF * bj + cw) * 2u) = pack8f(v); } EPI_FENCE(); }
        }
    }
};

struct EpiKvb {
    static constexpr bool PERM = true, AFTER_DRAIN = false;
    const ss_t* sskv; bf16_t* KB; bf16_t* VB;
    __device__ __forceinline__ void operator()(const f32x4 (&acc)[2][2][4][2], const Unit& u, int wr, int wc, int fr, int fq) const {
        asm volatile("" : "+v"(fr), "+v"(fq));
        const int row0 = u.pm * BM + wr * 64 + fr, head = u.pn, cw = wc * 32 + 8 * fq;
#pragma unroll
        for (int ai = 0; ai < 2; ++ai)
#pragma unroll
            for (int m = 0; m < 4; ++m) { const int row = row0 + ai * HALF + m * 16; const float rs2 = rsq(ss_get(AT(const ss_t, sskv, row * 8u)) * (1.f / KVR) + EPS);
                float v[8]; EPI_V8(v, ai, 0, m, rs2); *AT(u32x4, KB, (unsigned)row * 3072u + (head * 192 + cw) * 2u) = pack8f(v);
                EPI_V8(v, ai, 1, m, rs2); *AT(u32x4, VB, (unsigned)row * 2048u + (head * 128 + cw) * 2u) = pack8f(v); EPI_FENCE(); }
    }
};

template <class Epi, class Sched, bool ALIGN_EPI = false, bool SP2 = false>
__device__ __forceinline__ void gemm_phase(PG8_LAS unsigned char* lds, const Gemm g, const Sched& S, const Epi& E) {
    int tid_ = threadIdx.x; asm volatile("" : "+v"(tid_));
    const int tid = tid_, wid = __builtin_amdgcn_readfirstlane(tid >> 6), lane = tid & 63, wr = wid >> 2, wc = wid & 3, fr = lane & 15, fq = lane >> 4;
    const int K = g.K, nt = K / BK;
    unsigned voffA[2], voffB[2];
#pragma unroll
    for (int i = 0; i < 2; ++i) { int R, C; stage_rc(tid * 16 + i * 8192, R, C); const int Rb = Epi::PERM ? ((R & ~31) + perm32(R & 31)) : R;
        voffA[i] = (unsigned)(R * K + C) * 2u; voffB[i] = (unsigned)(Rb * K + C) * 2u; }
    const size_t kstep = (size_t)(BK * 2);
    const size_t hstep = (size_t)HALF * K * 2;
    const size_t tstep = 2 * hstep;
    const unsigned ldsw = (unsigned)wid * 1024u;
    const int aoff = lds_byte(wr * 64 + fr, fq * 8), boff = lds_byte(wc * 32 + fr, fq * 8);
#define PG8_SA(b, h) (((b) * 2 + (h)) * HTB)
#define PG8_SB(b, h) ((4 + (b) * 2 + (h)) * HTB)
#define PG8_STAGE(bufoff, gbase, voff) do { _Pragma("unroll") for (int _i = 0; _i < 2; ++_i) \
        __builtin_amdgcn_global_load_lds((const unsigned*)((const char*)(gbase) + (voff)[_i]), (PG8_LAS unsigned*)(lds + (bufoff) + ldsw + _i * 8192), 16, 0, 0); } while (0)
#define PG8_LDA(dst, b, h) do { _Pragma("unroll") for (int m = 0; m < 4; ++m) _Pragma("unroll") for (int k = 0; k < 2; ++k) dst[m][k] = *(const PG8_LAS bf16x8*)(lds + PG8_SA(b, h) + aoff + m * 2048 + k * 1024); } while (0)
#define PG8_LDB(dst, b, h) do { _Pragma("unroll") for (int n = 0; n < 2; ++n) _Pragma("unroll") for (int k = 0; k < 2; ++k) dst[n][k] = *(const PG8_LAS bf16x8*)(lds + PG8_SB(b, h) + boff + n * 2048 + k * 1024); } while (0)
#define PG8_MMA(ai, bj, At, Bt) do { __builtin_amdgcn_s_setprio(1); _Pragma("unroll") for (int m = 0; m < 4; ++m) _Pragma("unroll") for (int n = 0; n < 2; ++n) _Pragma("unroll") for (int k = 0; k < 2; ++k) \
        acc[ai][bj][m][n] = __builtin_amdgcn_mfma_f32_16x16x32_bf16(Bt[n][k], At[m][k], acc[ai][bj][m][n], 0, 0, 0); __builtin_amdgcn_s_setprio(0); } while (0)
#define PG8_WAIT_V(n) asm volatile("s_waitcnt vmcnt(" #n ")" ::: "memory")
#define PG8_WAIT_L(n) asm volatile("s_waitcnt lgkmcnt(" #n ")" ::: "memory")
#define PG8_BAR __builtin_amdgcn_s_barrier()
#define PG8_SCHED __builtin_amdgcn_sched_barrier(0)
    Unit cur, nxt; int ui = 0;
    if (!S.next(0, cur)) return;
    f32x4 acc[2][2][4][2];
#pragma unroll
    for (int a = 0; a < 2; ++a)
#pragma unroll
        for (int b = 0; b < 2; ++b)
#pragma unroll
            for (int m = 0; m < 4; ++m)
#pragma unroll
                for (int n = 0; n < 2; ++n) acc[a][b][m][n] = (f32x4){0.f, 0.f, 0.f, 0.f};
    bf16x8 At[4][2], B0[2][2], B1[2][2];
    const char* cA = (const char*)g.A + (size_t)cur.pm * tstep; const char* cB = (const char*)g.Bt + (size_t)cur.pn * tstep;
    S.a_ready(cur);
    if constexpr (SP2) {
        PG8_STAGE(PG8_SB(0, 0), cB, voffB); PG8_STAGE(PG8_SB(0, 1), cB + hstep, voffB); PG8_STAGE(PG8_SA(0, 0), cA, voffA); PG8_STAGE(PG8_SA(0, 1), cA + hstep, voffA);
        if (wr == 1) PG8_BAR;
        PG8_WAIT_V(2); PG8_BAR;
        PG8_STAGE(PG8_SB(1, 0), cB + kstep, voffB); PG8_STAGE(PG8_SA(1, 0), cA + kstep, voffA); PG8_STAGE(PG8_SB(1, 1), cB + hstep + kstep, voffB);
        PG8_WAIT_V(6); PG8_BAR;
    } else {
        PG8_STAGE(PG8_SB(0, 0), cB, voffB); PG8_STAGE(PG8_SA(0, 0), cA, voffA); PG8_STAGE(PG8_SB(0, 1), cB + hstep, voffB); PG8_STAGE(PG8_SA(0, 1), cA + hstep, voffA);
        if (wr == 1) PG8_BAR;
        PG8_WAIT_V(4); PG8_BAR;
        PG8_STAGE(PG8_SB(1, 0), cB + kstep, voffB); PG8_STAGE(PG8_SA(1, 0), cA + kstep, voffA); PG8_STAGE(PG8_SB(1, 1), cB + hstep + kstep, voffB);
        PG8_WAIT_V(6); PG8_BAR;
    }
    for (;;) {
        const bool has_next = S.next(ui + 1, nxt);
        const char* nA = has_next ? (const char*)g.A + (size_t)nxt.pm * tstep : cA; const char* nB = has_next ? (const char*)g.Bt + (size_t)nxt.pn * tstep : cB;
        for (int t = 0; t < nt; t += 2) {
            const bool last = (t == nt - 2);
            const char* a1 = cA + (size_t)(t + 1) * kstep;
            const char* a2 = last ? nA : cA + (size_t)(t + 2) * kstep; const char* b2 = last ? nB : cB + (size_t)(t + 2) * kstep;
            const char* a3 = a2 + kstep; const char* b3 = b2 + kstep;
            if (last && has_next) S.a_ready(nxt);
            if constexpr (SP2) {
            PG8_LDB(B0, 0, 0); PG8_LDB(B1, 0, 1); PG8_SCHED; PG8_LDA(At, 0, 0); PG8_STAGE(PG8_SA(1, 1), a1 + hstep, voffA);
            PG8_WAIT_V(8); PG8_WAIT_L(0); PG8_BAR; PG8_MMA(0, 0, At, B0); PG8_MMA(0, 1, At, B1); PG8_BAR; PG8_SCHED;
            PG8_LDA(At, 0, 1); PG8_STAGE(PG8_SB(0, 0), b2, voffB); PG8_STAGE(PG8_SB(0, 1), b2 + hstep, voffB); PG8_STAGE(PG8_SA(0, 0), a2, voffA);
            PG8_WAIT_V(8); PG8_WAIT_L(0); PG8_BAR; PG8_MMA(1, 0, At, B0); PG8_MMA(1, 1, At, B1); PG8_BAR; PG8_SCHED;
            PG8_LDB(B0, 1, 0); PG8_LDB(B1, 1, 1); PG8_SCHED; PG8_LDA(At, 1, 0); PG8_STAGE(PG8_SA(0, 1), a2 + hstep, voffA);
            PG8_WAIT_V(8); PG8_WAIT_L(0); PG8_BAR; PG8_MMA(0, 0, At, B0); PG8_MMA(0, 1, At, B1); PG8_BAR; PG8_SCHED;
            PG8_LDA(At, 1, 1); PG8_STAGE(PG8_SB(1, 0), b3, voffB); PG8_STAGE(PG8_SB(1, 1), b3 + hstep, voffB); PG8_STAGE(PG8_SA(1, 0), a3, voffA);
            PG8_WAIT_V(8); PG8_WAIT_L(0); PG8_BAR; PG8_MMA(1, 0, At, B0); PG8_MMA(1, 1, At, B1); PG8_BAR; PG8_SCHED;
            } else {
            PG8_LDB(B0, 0, 0); PG8_SCHED; PG8_LDA(At, 0, 0); PG8_STAGE(PG8_SA(1, 1), a1 + hstep, voffA);
            PG8_WAIT_L(8); PG8_BAR; PG8_WAIT_L(0); PG8_MMA(0, 0, At, B0); PG8_BAR; PG8_SCHED;
            PG8_LDB(B1, 0, 1); PG8_STAGE(PG8_SB(0, 0), b2, voffB);
            PG8_BAR; PG8_WAIT_L(0); PG8_MMA(0, 1, At, B1); PG8_BAR;
            PG8_LDA(At, 0, 1); PG8_STAGE(PG8_SA(0, 0), a2, voffA);
            PG8_BAR; PG8_WAIT_L(0); PG8_MMA(1, 0, At, B0); PG8_BAR; PG8_SCHED;
            PG8_STAGE(PG8_SB(0, 1), b2 + hstep, voffB);
            PG8_WAIT_V(6); PG8_BAR; PG8_MMA(1, 1, At, B1); PG8_BAR;
            PG8_LDB(B0, 1, 0); PG8_SCHED; PG8_LDA(At, 1, 0); PG8_STAGE(PG8_SA(0, 1), a2 + hstep, voffA);
            PG8_WAIT_L(8); PG8_BAR; PG8_WAIT_L(0); PG8_MMA(0, 0, At, B0); PG8_BAR; PG8_SCHED;
            PG8_LDB(B1, 1, 1); PG8_STAGE(PG8_SB(1, 0), b3, voffB);
            PG8_BAR; PG8_WAIT_L(0); PG8_MMA(0, 1, At, B1); PG8_BAR;
            PG8_LDA(At, 1, 1); PG8_STAGE(PG8_SA(1, 0), a3, voffA);
            PG8_BAR; PG8_WAIT_L(0); PG8_MMA(1, 0, At, B0); PG8_BAR; PG8_SCHED;
            PG8_STAGE(PG8_SB(1, 1), b3 + hstep, voffB);
            PG8_WAIT_V(6); PG8_BAR; PG8_MMA(1, 1, At, B1); PG8_BAR;
            }
        }
        if constexpr (ALIGN_EPI) { if (wr == 0) PG8_BAR; }
        if constexpr (!Epi::AFTER_DRAIN) { E(acc, cur, wr, wc, fr, fq); S.done(cur); }
        if (!has_next) break;
#pragma unroll
        for (int a = 0; a < 2; ++a)
#pragma unroll
            for (int b = 0; b < 2; ++b)
#pragma unroll
                for (int m = 0; m < 4; ++m)
#pragma unroll
                    for (int n = 0; n < 2; ++n) acc[a][b][m][n] = (f32x4){0.f, 0.f, 0.f, 0.f};
        cur = nxt; cA = nA; cB = nB; ++ui;
        if constexpr (ALIGN_EPI) { if (wr == 1) PG8_BAR; }
    }
    PG8_WAIT_V(0);
    if constexpr (!ALIGN_EPI) { if (wr == 0) PG8_BAR; }
    PG8_BAR;
    if constexpr (Epi::AFTER_DRAIN) { E.fused(acc, cur, wr, wc, fr, fq, lds, wid, lane); S.done(cur); }
#undef PG8_SA
#undef PG8_SB
#undef PG8_STAGE
#undef PG8_LDA
#undef PG8_LDB
#undef PG8_MMA
#undef PG8_WAIT_V
#undef PG8_WAIT_L
#undef PG8_BAR
#undef PG8_SCHED
}
}

#define GAS __attribute__((address_space(1)))
#define LAS __attribute__((address_space(3)))
typedef unsigned short bf16_t;
typedef short bf16x8 __attribute__((ext_vector_type(8)));
typedef short s16x4 __attribute__((ext_vector_type(4)));
typedef float f32x2 __attribute__((ext_vector_type(2)));
typedef float f32x4 __attribute__((ext_vector_type(4)));
typedef float f32x16 __attribute__((ext_vector_type(16)));
typedef unsigned u32x2 __attribute__((ext_vector_type(2)));
typedef unsigned u32x4 __attribute__((ext_vector_type(4)));
typedef GAS unsigned gu32;
#define RLX_AGENT __ATOMIC_RELAXED, __HIP_MEMORY_SCOPE_AGENT
#define LDS_WAIT() asm volatile("s_waitcnt lgkmcnt(0)" ::: "memory")
#define VM_WAIT() asm volatile("s_waitcnt vmcnt(0)" ::: "memory")
#define SBAR() __builtin_amdgcn_sched_barrier(0)
__device__ __forceinline__ unsigned cvtpk(float lo, float hi) { unsigned r; asm volatile("v_cvt_pk_bf16_f32 %0, %1, %2" : "=v"(r) : "v"(lo), "v"(hi)); return r; }
__device__ __forceinline__ float bflo(unsigned w) { return __builtin_bit_cast(float, w << 16); }
__device__ __forceinline__ float bfhi(unsigned w) { return __builtin_bit_cast(float, w & 0xffff0000u); }
__device__ __forceinline__ int crow(int r, int hi) { return (r & 3) + 8 * (r >> 2) + 4 * hi; }
__device__ __forceinline__ float ex2f(float x) { return __builtin_amdgcn_exp2f(x); }
__device__ __forceinline__ float wave_sum(float v) {
#pragma unroll
    for (int o = 1; o < 64; o <<= 1) v += __shfl_xor(v, o);
    return v;
}
#define PK4(P, B_, OUT) do { unsigned a0_ = cvtpk(P[B_+0], P[B_+1]), a1_ = cvtpk(P[B_+2], P[B_+3]); unsigned b0_ = cvtpk(P[B_+4], P[B_+5]), b1_ = cvtpk(P[B_+6], P[B_+7]); \
        auto r0_ = __builtin_amdgcn_permlane32_swap(a0_, b0_, false, false); auto r1_ = __builtin_amdgcn_permlane32_swap(a1_, b1_, false, false); \
        u32x4 w_ = {r0_[0], r1_[0], r0_[1], r1_[1]}; OUT = __builtin_bit_cast(bf16x8, w_); } while (0)


namespace att {
constexpr int KTB = 64 * 384, VTB = 64 * 256;
constexpr int L_K0 = 0, L_K1 = KTB, L_V0 = 2 * KTB, L_V1 = 2 * KTB + VTB, L_WS = 2 * KTB + 2 * VTB, LDS_BYTES = L_WS + 8 * 64 * 4;
__device__ __forceinline__ int v_st(int k, int c) { const int kk = (k & ~0xC) | ((k & 4) << 1) | ((k & 8) >> 1); return ((kk >> 3) * 4 + (c >> 5)) * 512 + ((kk & 7) * 32 + (c & 31)) * 2; }
__device__ __forceinline__ int v_rd_base(int lane) { return ((lane & 3) << 3) | (((lane >> 2) & 3) << 6) | (((lane >> 4) & 1) << 5) | (((lane >> 5) & 1) << 8); }
constexpr int v_rd_off(int d0, int ks, int half) { return d0 * 512 + ks * 4096 + half * 2048; }

template <int KBUF>
__device__ __forceinline__ void qkt(f32x16& p0, f32x16& p1, LAS const unsigned char* lds, int r32, int hi, const bf16x8* qr) {
    p0 = f32x16{}; p1 = f32x16{};
    const int x = ((r32 >> 1) & 7) << 4;
    LAS const unsigned char* kb[4];
#pragma unroll
    for (int dd = 0; dd < 4; ++dd) kb[dd] = lds + KBUF * KTB + r32 * 384 + ((dd * 32 + hi * 16) ^ x);
#pragma unroll
    for (int d0 = 0; d0 < 12; ++d0) { LAS const unsigned char* a = kb[d0 & 3] + (d0 >> 2) * 128;
        const bf16x8 b0 = *(LAS const bf16x8*)a, b1 = *(LAS const bf16x8*)(a + 32 * 384);
        p0 = __builtin_amdgcn_mfma_f32_32x32x16_bf16(b0, qr[d0], p0, 0, 0, 0);
        p1 = __builtin_amdgcn_mfma_f32_32x32x16_bf16(b1, qr[d0], p1, 0, 0, 0); }
}
template <int VBUF>
__device__ __forceinline__ void pv_tile(f32x16* o, int vb0, bf16x8 pa0, bf16x8 pa1, bf16x8 pa2, bf16x8 pa3) {
#define TRRD(dst, off) asm volatile("ds_read_b64_tr_b16 %0, %1 offset:%2" : "=&v"(dst) : "v"(vb0), "i"(off) : "memory")
#define PV_D0(d0) do { s16x4 l0, l1, l2, l3, h0, h1, h2, h3; constexpr int b_ = VBUF * VTB + v_rd_off(d0, 0, 0); \
        TRRD(l0, b_); TRRD(h0, b_ + 2048); TRRD(l1, b_ + 4096); TRRD(h1, b_ + 6144); TRRD(l2, b_ + 8192); TRRD(h2, b_ + 10240); TRRD(l3, b_ + 12288); TRRD(h3, b_ + 14336); \
        asm volatile("s_waitcnt lgkmcnt(0)" ::: "memory"); SBAR(); \
        o[d0] = __builtin_amdgcn_mfma_f32_32x32x16_bf16(pa0, (bf16x8){l0[0], l0[1], l0[2], l0[3], h0[0], h0[1], h0[2], h0[3]}, o[d0], 0, 0, 0); \
        o[d0] = __builtin_amdgcn_mfma_f32_32x32x16_bf16(pa1, (bf16x8){l1[0], l1[1], l1[2], l1[3], h1[0], h1[1], h1[2], h1[3]}, o[d0], 0, 0, 0); \
        o[d0] = __builtin_amdgcn_mfma_f32_32x32x16_bf16(pa2, (bf16x8){l2[0], l2[1], l2[2], l2[3], h2[0], h2[1], h2[2], h2[3]}, o[d0], 0, 0, 0); \
        o[d0] = __builtin_amdgcn_mfma_f32_32x32x16_bf16(pa3, (bf16x8){l3[0], l3[1], l3[2], l3[3], h3[0], h3[1], h3[2], h3[3]}, o[d0], 0, 0, 0); } while (0)
    PV_D0(0); PV_D0(1); PV_D0(2); PV_D0(3);
#undef PV_D0
#undef TRRD
}

__device__ __forceinline__ void attn_unit(LAS unsigned char* lds, const bf16_t* __restrict__ QB, const bf16_t* __restrict__ KB, const bf16_t* __restrict__ VB,
                                          bf16_t* __restrict__ CAT, const float* __restrict__ onw, int b, int h, int qb) {
    int tid_ = threadIdx.x; asm volatile("" : "+v"(tid_));
    const int tid = tid_, wid = __builtin_amdgcn_readfirstlane(tid >> 6), lane = tid & 63, r32 = lane & 31, hi = lane >> 5;
    const int NT = 4 * (qb + 1);
    const int qlo = qb * 256 + wid * 32;
    const size_t tok0 = (size_t)b * SEQ;
    LAS float* wsf = (LAS float*)(lds + L_WS) + wid * 64; LAS float* li_l = wsf; LAS float* al_l = wsf + 32;
    bf16x8 qr[12];
    { const bf16_t* qp = QB + (tok0 + qlo + r32) * 1536 + h * 192 + hi * 8;
#pragma unroll
      for (int d0 = 0; d0 < 12; ++d0) qr[d0] = *(const bf16x8*)(qp + d0 * 16); }
    const int skey = tid >> 3, sch = tid & 7, kls = skey * 384 + ((sch * 16) ^ (((skey >> 1) & 7) << 4));
    const bf16_t* kg = KB + (tok0 + skey) * 1536 + h * 192 + sch * 8;
    const int sr = tid >> 4, sc = (tid & 15) * 8, vst0 = v_st(sr, sc), vst1 = v_st(32 + sr, sc);
    const bf16_t* vg = VB + (tok0 + sr) * 1024 + h * 128 + sc;
    bf16x8 stK0, stK1, stK2, stV0, stV1;
#define A_LOAD(t) do { const bf16_t* kp_ = kg + (size_t)(t) * (64 * 1536); stK0 = *(const bf16x8*)kp_; stK1 = *(const bf16x8*)(kp_ + 64); stK2 = *(const bf16x8*)(kp_ + 128); \
        const bf16_t* vp_ = vg + (size_t)(t) * (64 * 1024); stV0 = *(const bf16x8*)vp_; stV1 = *(const bf16x8*)(vp_ + 32 * 1024); } while (0)
#define A_WRITE(KOFF, VOFF) do { *(LAS bf16x8*)(lds + (KOFF) + kls) = stK0; *(LAS bf16x8*)(lds + (KOFF) + kls + 128) = stK1; *(LAS bf16x8*)(lds + (KOFF) + kls + 256) = stK2; \
        *(LAS bf16x8*)(lds + (VOFF) + vst0) = stV0; *(LAS bf16x8*)(lds + (VOFF) + vst1) = stV1; } while (0)
    float m_reg = -1e30f, l_reg = 0.f; f32x16 o[4] = {};
    const int vb0 = (int)(unsigned)(uintptr_t)(lds + L_V0) + v_rd_base(lane);
    A_LOAD(0); A_WRITE(L_K0, L_V0); __syncthreads();
#define A_STEP(t, BUFI, NKOFF, NVOFF) do { \
        if ((t) + 1 < NT) A_LOAD((t) + 1); \
        const int kb_ = (t) * 64; \
        if (kb_ <= qlo + 31) {                                     \
            f32x16 p0, p1; qkt<BUFI>(p0, p1, lds, r32, hi, qr); \
            if (kb_ + 63 > qlo) { const int dq = qlo + r32 - kb_; const float NEG = -__builtin_inff(); \
                _Pragma("unroll") for (int r = 0; r < 16; ++r) { const int c = crow(r, hi); if (c > dq) p0[r] = NEG; if (c + 32 > dq) p1[r] = NEG; } } \
            float pmax = fmaxf(p0[0], p1[0]); \
            _Pragma("unroll") for (int r = 1; r < 16; ++r) pmax = fmaxf(pmax, fmaxf(p0[r], p1[r])); \
            { auto rr = __builtin_amdgcn_permlane32_swap(__float_as_uint(pmax), __float_as_uint(pmax), false, false); pmax = fmaxf(__uint_as_float(rr[0]), __uint_as_float(rr[1])); } \
            const float mn = fmaxf(m_reg, pmax), alpha = ex2f(m_reg - mn); m_reg = mn; \
            float ps = 0.f; \
            _Pragma("unroll") for (int r = 0; r < 16; ++r) { p0[r] = ex2f(p0[r] - mn); p1[r] = ex2f(p1[r] - mn); ps += p0[r] + p1[r]; } \
            { auto rr = __builtin_amdgcn_permlane32_swap(__float_as_uint(ps), __float_as_uint(ps), false, false); ps = __uint_as_float(rr[0]) + __uint_as_float(rr[1]); } \
            l_reg = l_reg * alpha + ps; \
            bf16x8 pa0, pa1, pa2, pa3; PK4(p0, 0, pa0); PK4(p0, 8, pa1); PK4(p1, 0, pa2); PK4(p1, 8, pa3); \
            if (__any(alpha < 1.f)) { if (hi == 0) al_l[r32] = alpha; LDS_WAIT(); \
                _Pragma("unroll") for (int r = 0; r < 16; ++r) { const float a_ = al_l[crow(r, hi)]; _Pragma("unroll") for (int d_ = 0; d_ < 4; ++d_) o[d_][r] *= a_; } } \
            pv_tile<BUFI>(o, vb0, pa0, pa1, pa2, pa3); } \
        if ((t) + 1 < NT) A_WRITE(NKOFF, NVOFF); \
        __syncthreads(); } while (0)
    for (int t = 0; t < NT; t += 2) { A_STEP(t, 0, L_K1, L_V1); A_STEP(t + 1, 1, L_K0, L_V0); }
#undef A_STEP
#undef A_LOAD
#undef A_WRITE
    if (hi == 0) li_l[r32] = l_reg;
    LDS_WAIT();
    float sq[16];
#pragma unroll
    for (int r = 0; r < 16; ++r) { const float rl = __builtin_amdgcn_rcpf(li_l[crow(r, hi)]); float s = 0.f;
#pragma unroll
        for (int d = 0; d < 4; ++d) { const float v = o[d][r] * rl; o[d][r] = v; s += v * v; }
        sq[r] = s; }
#pragma unroll
    for (int off = 1; off < 32; off <<= 1)
#pragma unroll
        for (int r = 0; r < 16; ++r) sq[r] += __shfl_xor(sq[r], off);
    float w[4];
#pragma unroll
    for (int d = 0; d < 4; ++d) w[d] = onw[h * 128 + d * 32 + r32];
    bf16_t* op = CAT + (tok0 + qlo) * DM + h * 128 + r32;
#pragma unroll
    for (int r = 0; r < 16; ++r) { const float rn = __builtin_amdgcn_rsqf(sq[r] * (1.f / 128.f) + EPS); const int orow = crow(r, hi);
#pragma unroll
        for (int d = 0; d < 4; ++d) { const float v = o[d][r] * rn * w[d]; const float vn = __shfl_xor(v, 1);
            if ((r32 & 1) == 0) *(unsigned*)(op + (size_t)orow * DM + d * 32) = cvtpk(v, vn); } }
}
}


namespace scan {
constexpr int QI = 0, KI = 16384, KTT = 32768, VTT = 49152, STT = 65536, OT = 98304, OT_LD = 132, TOT = OT + 64 * OT_LD * 4  , FA = TOT + 8 * 128 * 4  , FB = FA + 512, FR = FB + 512, LDS_BYTES = FR + 512;
__device__ __forceinline__ int sw256(int row, int colB) { return row * 256 + (colB ^ ((row & 15) << 4)); }
__device__ __forceinline__ int sw128(int row, int colB) { return row * 128 + (colB ^ (((row >> 1) & 7) << 4)); }

__device__ __forceinline__ void scan_item(LAS unsigned char* lds, int type, int b, int h, const bf16_t* __restrict__ Qg, const bf16_t* __restrict__ Kg, const bf16_t* __restrict__ Vg,
                                          const bf16_t* __restrict__ Gt, const float* __restrict__ LF, const float* __restrict__ nw, bf16_t* __restrict__ CAT, int cbase) {
    int tid_ = threadIdx.x; asm volatile("" : "+v"(tid_));
    const int tid = tid_, wid = __builtin_amdgcn_readfirstlane(tid >> 6), lane = tid & 63, r32 = lane & 31, hi = lane >> 5;
    const int ib = wid >> 2, eb = wid & 3, cg = lane, rg = wid;
    const float lg = log1pf(-exp2f(-5.f - (float)h));
    LAS float* tot = (LAS float*)(lds + TOT); LAS float* fa = (LAS float*)(lds + FA); LAS float* fb = (LAS float*)(lds + FB); LAS float* fr = (LAS float*)(lds + FR);
    LAS float* ot = (LAS float*)(lds + OT);
    f32x16 S0 = {}, S1 = {};
    const size_t tok0 = (size_t)b * SEQ;
    unsigned q[8], k[8], v[8]; f32x2 lf[8];
#define S_LOAD(c) do { _Pragma("unroll") for (int r = 0; r < 8; ++r) { const size_t off_ = (tok0 + (c) * 64 + 8 * rg + r) * 512 + h * 128 + 2 * cg; \
        q[r] = *(const unsigned*)(Qg + off_); k[r] = *(const unsigned*)(Kg + off_); v[r] = *(const unsigned*)(Vg + off_); \
        { const f32x2 l2_ = *(const f32x2*)(LF + off_); lf[r] = type ? l2_ : (f32x2){lg, lg}; } } } while (0)
    S_LOAD(0);
    for (int c = 0; c < SEQ / 64; ++c) {
        float c0[8], c1[8];
        { float a0 = 0.f, a1 = 0.f;
#pragma unroll
          for (int r = 0; r < 8; ++r) { a0 += lf[r].x; a1 += lf[r].y; c0[r] = a0; c1[r] = a1; } }
        *(LAS f32x2*)(tot + rg * 128 + 2 * cg) = (f32x2){c0[7], c1[7]};
        __syncthreads();
        float off0 = 0.f, off1 = 0.f, mid0 = 0.f, mid1 = 0.f, last0 = 0.f, last1 = 0.f;
#pragma unroll
        for (int g = 0; g < 8; ++g) { const f32x2 t2 = *(LAS const f32x2*)(tot + g * 128 + 2 * cg);
            if (g < rg) { off0 += t2.x; off1 += t2.y; } if (g < 4) { mid0 += t2.x; mid1 += t2.y; } last0 += t2.x; last1 += t2.y; }
        float kt0[8], kt1[8];
#pragma unroll
        for (int r = 0; r < 8; ++r) { const float b0 = off0 + c0[r], b1 = off1 + c1[r];
            const float qa = ex2f((b0 - mid0) * LOG2E), qb2 = ex2f((b1 - mid1) * LOG2E), ka = ex2f((mid0 - b0) * LOG2E), kb2 = ex2f((mid1 - b1) * LOG2E);
            const int row = 8 * rg + r;
            *(LAS unsigned*)(lds + QI + sw256(row, 4 * cg)) = cvtpk(bflo(q[r]) * qa, bfhi(q[r]) * qb2);
            kt0[r] = bflo(k[r]) * ka; kt1[r] = bfhi(k[r]) * kb2;
            *(LAS unsigned*)(lds + KI + sw256(row, 4 * cg)) = cvtpk(kt0[r], kt1[r]); }
        { u32x4 w0, w1, x0, x1;
          w0.x = cvtpk(kt0[0], kt0[1]); w0.y = cvtpk(kt0[2], kt0[3]); w0.z = cvtpk(kt0[4], kt0[5]); w0.w = cvtpk(kt0[6], kt0[7]);
          w1.x = cvtpk(kt1[0], kt1[1]); w1.y = cvtpk(kt1[2], kt1[3]); w1.z = cvtpk(kt1[4], kt1[5]); w1.w = cvtpk(kt1[6], kt1[7]);
          x0.x = (v[0] & 0xffffu) | (v[1] << 16); x0.y = (v[2] & 0xffffu) | (v[3] << 16); x0.z = (v[4] & 0xffffu) | (v[5] << 16); x0.w = (v[6] & 0xffffu) | (v[7] << 16);
          x1.x = (v[0] >> 16) | (v[1] & 0xffff0000u); x1.y = (v[2] >> 16) | (v[3] & 0xffff0000u); x1.z = (v[4] >> 16) | (v[5] & 0xffff0000u); x1.w = (v[6] >> 16) | (v[7] & 0xffff0000u);
          *(LAS u32x4*)(lds + KTT + sw128(2 * cg, 16 * rg)) = w0; *(LAS u32x4*)(lds + KTT + sw128(2 * cg + 1, 16 * rg)) = w1;
          *(LAS u32x4*)(lds + VTT + sw128(2 * cg, 16 * rg)) = x0; *(LAS u32x4*)(lds + VTT + sw128(2 * cg + 1, 16 * rg)) = x1; }
        if (rg == 0) { *(LAS f32x2*)(fa + 2 * cg) = (f32x2){ex2f(last0 * LOG2E), ex2f(last1 * LOG2E)};
                       *(LAS f32x2*)(fb + 2 * cg) = (f32x2){ex2f((last0 - mid0) * LOG2E), ex2f((last1 - mid1) * LOG2E)};
                       *(LAS f32x2*)(fr + 2 * cg) = (f32x2){ex2f(mid0 * LOG2E), ex2f(mid1 * LOG2E)}; }
        if (c + 1 < SEQ / 64) S_LOAD(c + 1);
        __syncthreads();
        { const int e = 32 * eb + r32;
#pragma unroll
          for (int blk = 0; blk < 2; ++blk) { const f32x16& Sb = blk ? S1 : S0; const int db = 2 * ib + blk;
#pragma unroll
            for (int g = 0; g < 4; ++g) { const int d0 = 32 * db + 8 * g + 4 * hi; const f32x4 f = *(LAS const f32x4*)(fr + d0);
                u32x2 w; w.x = cvtpk(Sb[4 * g] * f[0], Sb[4 * g + 1] * f[1]); w.y = cvtpk(Sb[4 * g + 2] * f[2], Sb[4 * g + 3] * f[3]);
                *(LAS u32x2*)(lds + STT + sw256(e, 2 * d0)) = w; } } }
        __syncthreads();
        { const int i = 32 * ib + r32, e = 32 * eb + r32;
          bf16x8 qf[8];
#pragma unroll
          for (int s = 0; s < 8; ++s) qf[s] = *(LAS const bf16x8*)(lds + QI + sw256(i, 32 * s + 16 * hi));
          f32x16 O = {};
#pragma unroll
          for (int s = 0; s < 8; ++s) { const bf16x8 sf = *(LAS const bf16x8*)(lds + STT + sw256(e, 32 * s + 16 * hi)); O = __builtin_amdgcn_mfma_f32_32x32x16_bf16(qf[s], sf, O, 0, 0, 0); }
#pragma unroll
          for (int jb = 0; jb < 2; ++jb) if (jb <= ib) {
              f32x16 pT = {}; const int j = 32 * jb + r32;
#pragma unroll
              for (int s = 0; s < 8; ++s) { const bf16x8 kf = *(LAS const bf16x8*)(lds + KI + sw256(j, 32 * s + 16 * hi)); pT = __builtin_amdgcn_mfma_f32_32x32x16_bf16(kf, qf[s], pT, 0, 0, 0); }
              if (jb == ib) {
#pragma unroll
                  for (int r = 0; r < 16; ++r) if (crow(r, hi) > r32) pT[r] = 0.f; }
              bf16x8 pa0, pa1; PK4(pT, 0, pa0); PK4(pT, 8, pa1);
              const bf16x8 vf0 = *(LAS const bf16x8*)(lds + VTT + sw128(e, 64 * jb + 16 * hi)), vf1 = *(LAS const bf16x8*)(lds + VTT + sw128(e, 64 * jb + 32 + 16 * hi));
              O = __builtin_amdgcn_mfma_f32_32x32x16_bf16(pa0, vf0, O, 0, 0, 0); O = __builtin_amdgcn_mfma_f32_32x32x16_bf16(pa1, vf1, O, 0, 0, 0); }
#pragma unroll
          for (int r = 0; r < 16; ++r) ot[(32 * ib + crow(r, hi)) * OT_LD + e] = O[r];
#pragma unroll
          for (int blk = 0; blk < 2; ++blk) { const int db = 2 * ib + blk, d = 32 * db + r32; f32x16 T = {};
#pragma unroll
            for (int s = 0; s < 4; ++s) { const bf16x8 kf = *(LAS const bf16x8*)(lds + KTT + sw128(d, 32 * s + 16 * hi)), vf = *(LAS const bf16x8*)(lds + VTT + sw128(e, 32 * s + 16 * hi));
                T = __builtin_amdgcn_mfma_f32_32x32x16_bf16(kf, vf, T, 0, 0, 0); }
#pragma unroll
            for (int g = 0; g < 4; ++g) { const int d0 = 32 * db + 8 * g + 4 * hi; const f32x4 a4 = *(LAS const f32x4*)(fa + d0), b4 = *(LAS const f32x4*)(fb + d0);
#pragma unroll
                for (int jj = 0; jj < 4; ++jj) { if (blk) S1[4 * g + jj] = S1[4 * g + jj] * a4[jj] + T[4 * g + jj] * b4[jj]; else S0[4 * g + jj] = S0[4 * g + jj] * a4[jj] + T[4 * g + jj] * b4[jj]; } } } }
        __syncthreads();
        { const int row = tid >> 3, seg = tid & 7; const LAS float* op = ot + row * OT_LD + 16 * seg;
          float x[16];
#pragma unroll
          for (int i4 = 0; i4 < 4; ++i4) { const f32x4 t4 = *(LAS const f32x4*)(op + 4 * i4); x[4 * i4] = t4[0]; x[4 * i4 + 1] = t4[1]; x[4 * i4 + 2] = t4[2]; x[4 * i4 + 3] = t4[3]; }
          float s1 = 0.f;
#pragma unroll
          for (int i = 0; i < 16; ++i) s1 += x[i];
          s1 += __shfl_xor(s1, 1); s1 += __shfl_xor(s1, 2); s1 += __shfl_xor(s1, 4);
          const float mu = type ? 0.f : s1 * (1.f / 128.f);
          float s2 = 0.f;
#pragma unroll
          for (int i = 0; i < 16; ++i) { x[i] -= mu; s2 += x[i] * x[i]; }
          s2 += __shfl_xor(s2, 1); s2 += __shfl_xor(s2, 2); s2 += __shfl_xor(s2, 4);
          const float rn = __builtin_amdgcn_rsqf(s2 * (1.f / 128.f) + EPS);
          const size_t grow = tok0 + c * 64 + row;
          const u32x4 g0 = *(const u32x4*)(Gt + grow * 512 + h * 128 + 16 * seg), g1 = *(const u32x4*)(Gt + grow * 512 + h * 128 + 16 * seg + 8);
          const unsigned gw[8] = {g0.x, g0.y, g0.z, g0.w, g1.x, g1.y, g1.z, g1.w};
          const float* wp = nw + h * 128 + 16 * seg;
          unsigned ow[8];
#pragma unroll
          for (int p = 0; p < 8; ++p) ow[p] = cvtpk(x[2 * p] * rn * wp[2 * p] * bflo(gw[p]), x[2 * p + 1] * rn * wp[2 * p + 1] * bfhi(gw[p]));
          bf16_t* cp = CAT + grow * DM + cbase + h * 128 + 16 * seg;
          *(u32x4*)cp = (u32x4){ow[0], ow[1], ow[2], ow[3]}; *(u32x4*)(cp + 8) = (u32x4){ow[4], ow[5], ow[6], ow[7]}; }
    }
#undef S_LOAD
    __syncthreads();
}
}


constexpr size_t MiB = 1u << 20;
constexpr size_t WS_CTL = 0, CTL_ZERO_BYTES = 4 * MiB;
constexpr int CW_TMO = 0, CW_BAR = 4096, CW_QHEAD = 8192;
constexpr size_t WS_SS = 1 * MiB;
constexpr size_t WS_TAB = 4 * MiB;
constexpr size_t TAB_CM = 0, TAB_SM = 262144, TAB_CR = 524288, TAB_SR = 1048576, TAB_LB = 1572864;
constexpr size_t WS_W = 8 * MiB, W_LAYER = 167 * MiB;
constexpr size_t W_UP1 = 0, W_DN1 = 44 * MiB, W_IN = 66 * MiB, W_KVB = 91 * MiB, W_O = 93 * MiB, W_UP2 = 101 * MiB, W_DN2 = 145 * MiB;
constexpr size_t WS_HB = WS_W + 4 * W_LAYER;
constexpr size_t WS_ACT = WS_HB + 64 * MiB;
constexpr size_t A_QB = 0, A_KB = 48 * MiB, A_VB = 96 * MiB, A_CKV = 128 * MiB, A_RQ = 144 * MiB, A_RK = 160 * MiB, A_RV = 176 * MiB, A_RG = 192 * MiB,
                 A_HQ = 208 * MiB, A_HK = 224 * MiB, A_HV = 240 * MiB, A_HG = 256 * MiB, A_HLF = 272 * MiB, A_CAT = 304 * MiB, A_END = 368 * MiB;
constexpr size_t WS_END = WS_ACT + A_END;
static_assert(A_RK - A_RQ == (size_t)M * 512 * 2 && A_HG - A_RQ == 7 * (A_RK - A_RQ) && TAB_SM == 65536 * 4 && TAB_CR == 131072 * 4 && TAB_SR == 262144 * 4, "EpiIn indexes these by stride");
static_assert((size_t)NUP * DM * 2 == 44 * MiB && (size_t)DM * DFF * 2 == 22 * MiB && (size_t)NIN * DM * 2 == 25 * MiB && (size_t)M * DFF * 2 <= A_END, "d_ws map");

constexpr int LDS_BYTES = 147456;
constexpr int MISC_OFF = LDS_BYTES - 256;
static_assert(scan::LDS_BYTES <= MISC_OFF && att::LDS_BYTES <= MISC_OFF && pg8::STAGE_BYTES <= MISC_OFF, "LDS map");

__device__ __forceinline__ int map_in(int s) {
    if (s < 1536) { const int head = s / 192, d = s - head * 192; if (d < 128) return head * 128 + d; const int rd = d - 128; return 1024 + head * 64 + (rd < 32 ? 2 * rd : 2 * (rd - 32) + 1); }
    if (s < 2048) return s;
    if (s < 2112) { const int rd = s - 2048; return 2048 + (rd < 32 ? 2 * rd : 2 * (rd - 32) + 1); }
    if (s < 3136) { const int e = s - 2112, hh = e >> 7, rd = e & 127; return 2304 + hh * 128 + (rd < 64 ? 2 * rd : 2 * (rd - 64) + 1); }
    return s + 192;
}
__device__ __forceinline__ void tr_item(const float* __restrict__ W, int K, int N, const float* __restrict__ g, bf16_t* __restrict__ WT, int kind, int item, LAS float* scr, int lane) {
    const int nblk = N >> 6, kb = item / nblk, nb = item - kb * nblk, k0 = 64 * kb, n0 = 64 * nb;
    { const int kr = lane >> 4, c4 = 4 * (lane & 15); const float* src = W + (size_t)(k0 + kr) * N + n0 + c4;
#pragma unroll 4
      for (int i = 0; i < 16; ++i) { const f32x4 v = *(const f32x4*)(src + (size_t)(4 * i) * N); LAS float* d = scr + (4 * i + kr) * 65 + c4; d[0] = v[0]; d[1] = v[1]; d[2] = v[2]; d[3] = v[3]; } }
    LDS_WAIT(); asm volatile("" ::: "memory");
    const int nn = lane & 7, c = lane >> 3;
    float gk[8];
    if (g) { const f32x4 g0 = *(const f32x4*)(g + k0 + 8 * c), g1 = *(const f32x4*)(g + k0 + 8 * c + 4); gk[0] = g0[0]; gk[1] = g0[1]; gk[2] = g0[2]; gk[3] = g0[3]; gk[4] = g1[0]; gk[5] = g1[1]; gk[6] = g1[2]; gk[7] = g1[3]; }
    else {
#pragma unroll
        for (int i = 0; i < 8; ++i) gk[i] = 1.f; }
#pragma unroll
    for (int j = 0; j < 8; ++j) { const int n = nn + 8 * j, ns = n0 + n; const LAS float* s = scr + (8 * c) * 65 + n;
        int dr = ns; if (kind == 1) dr = 256 * (ns >> 7) + (ns & 127); else if (kind == 2) dr = 256 * (ns >> 7) + (ns & 127) + 128; else if (kind == 3) dr = map_in(ns);
        u32x4 o; o.x = cvtpk(s[0] * gk[0], s[65] * gk[1]); o.y = cvtpk(s[2 * 65] * gk[2], s[3 * 65] * gk[3]); o.z = cvtpk(s[4 * 65] * gk[4], s[5 * 65] * gk[5]); o.w = cvtpk(s[6 * 65] * gk[6], s[7 * 65] * gk[7]);
        *(u32x4*)(WT + (size_t)dr * K + k0 + 8 * c) = o; }
    LDS_WAIT(); asm volatile("" ::: "memory");
}

#define XB_TMO      128
#define XB_XCNT(j)  (256  + 64 * (j))
#define XB_XSUB(j)  (1280 + 64 * (j))
#define XB_XGEN(j)  (2304 + 64 * (j))
#define XB_TOP      3328
#define XB_TOPGEN   3392
#define XCD_BAR_WORDS 3456
#define XB_SPIN_CAP (1u << 18)

__device__ __forceinline__ unsigned xb_ld(unsigned* p)              { return __hip_atomic_load(p, __ATOMIC_RELAXED, __HIP_MEMORY_SCOPE_AGENT); }
__device__ __forceinline__ unsigned xb_add(unsigned* p, unsigned v) { return __hip_atomic_fetch_add(p, v, __ATOMIC_RELAXED, __HIP_MEMORY_SCOPE_AGENT); }
__device__ __forceinline__ unsigned xb_xcc_id() { return (unsigned)__builtin_amdgcn_s_getreg((3 << 11) | 20) & 0xFu; }
#define XB_SPIN(cond, bar) do { unsigned _sp = 0; while (cond) { __builtin_amdgcn_s_sleep(1); \
    if ((++_sp & 255u) == 0u) { if (xb_ld(&(bar)[XB_TMO])) break; if (_sp > XB_SPIN_CAP) { atomicAdd(&(bar)[XB_TMO], 1u); break; } } } } while (0)

struct XcdBarrier {
    unsigned* bar; unsigned x;
    volatile LAS unsigned* st;
};

__device__ __forceinline__ XcdBarrier xcd_barrier_post(unsigned* bar, volatile LAS unsigned* st) {
    XcdBarrier b; b.bar = bar; b.x = xb_xcc_id(); b.st = st;
    if (threadIdx.x == 0) (void)xb_add(&bar[XB_XCNT(b.x)], 1u);
    return b;
}
__device__ __forceinline__ void xcd_barrier_complete(unsigned* bar, unsigned x, unsigned& nloc, unsigned& nx) {
    const unsigned G = gridDim.x * gridDim.y * gridDim.z;
    unsigned sum, cnt, mine, sp = 0u;
    for (;;) {
        sum = 0u; cnt = 0u; mine = 0u;
#pragma unroll
        for (unsigned j = 0; j < 16; ++j) { const unsigned c = xb_ld(&bar[XB_XCNT(j)]); sum += c; cnt += (c > 0u) ? 1u : 0u; mine = (j == x) ? c : mine; }
        if (sum == G) break;
        __builtin_amdgcn_s_sleep(1);
        if ((++sp & 255u) == 0u) { if (xb_ld(&bar[XB_TMO])) break; if (sp > XB_SPIN_CAP) { atomicAdd(&bar[XB_TMO], 1u); break; } }
    }
    nloc = mine > 0u ? mine : 1u; nx = cnt > 0u ? cnt : 1u;
}

__device__ __forceinline__ void xcd_barrier(const XcdBarrier& b) {
    asm volatile("s_waitcnt vmcnt(0)" ::: "memory");
    __syncthreads();
    if (threadIdx.x == 0) {
        unsigned* bar = b.bar;
        __builtin_amdgcn_s_waitcnt(0);
        unsigned nloc = b.st[0], nx = b.st[1];
        if (nloc == 0u) { xcd_barrier_complete(bar, b.x, nloc, nx); b.st[0] = nloc; b.st[1] = nx; }
        const unsigned old = xb_add(&bar[XB_XSUB(b.x)], 1u);
        const unsigned gen = old / nloc;
        if (old + 1u == (gen + 1u) * nloc) {
            __builtin_amdgcn_fence(__ATOMIC_RELEASE, "agent");
            asm volatile("s_waitcnt vmcnt(0)" ::: "memory");
            const unsigned og = xb_add(&bar[XB_TOP], 1u);
            const unsigned tg = og / nx;
            if (og + 1u == (tg + 1u) * nx) xb_add(&bar[XB_TOPGEN], 1u);
            else XB_SPIN(xb_ld(&bar[XB_TOPGEN]) == tg, bar);
            __builtin_amdgcn_fence(__ATOMIC_ACQUIRE, "agent");
            xb_add(&bar[XB_XGEN(b.x)], 1u);
            asm volatile("s_waitcnt vmcnt(0)" ::: "memory");
        } else {
            XB_SPIN(xb_ld(&bar[XB_XGEN(b.x)]) == gen, bar);
            __builtin_amdgcn_fence(__ATOMIC_ACQUIRE, "agent");
            asm volatile("s_waitcnt vmcnt(0)" ::: "memory");
        }
    }
    __syncthreads();
}

__device__ __forceinline__ void sincos_d(float ang, float& s, float& c) {
    const double x = (double)ang, k = __builtin_rint(x * 0.6366197723675814), r = __builtin_fma(-k, 1.5707963267948966, x) - k * 6.123233995736766e-17, r2 = r * r;
    double sp = -1.0 / 6227020800.0; sp = sp * r2 + 1.0 / 39916800.0; sp = sp * r2 - 1.0 / 362880.0; sp = sp * r2 + 1.0 / 5040.0; sp = sp * r2 - 1.0 / 120.0; sp = sp * r2 + 1.0 / 6.0;
    const double sr = r - r * r2 * sp;
    double cp = 1.0 / 479001600.0; cp = cp * r2 - 1.0 / 3628800.0; cp = cp * r2 + 1.0 / 40320.0; cp = cp * r2 - 1.0 / 720.0; cp = cp * r2 + 1.0 / 24.0; cp = cp * r2 - 0.5;
    const double cr = 1.0 + r2 * cp;
    const int q = (int)k & 3;
    const double ss_ = (q == 0) ? sr : (q == 1) ? cr : (q == 2) ? -sr : -cr, cc_ = (q == 0) ? cr : (q == 1) ? -sr : (q == 2) ? -cr : sr;
    s = (float)ss_; c = (float)cc_;
}

#ifndef ALPHA_MASK
#define ALPHA_MASK 0xFFF
#endif
constexpr int NPH = 50;
struct Args { const float* in[19]; float* out; unsigned char* ws; int ph_lo, ph_hi; };
__global__ void __launch_bounds__(512, 2) mk_fwd(Args args) {
    extern __shared__ __attribute__((aligned(16))) unsigned char lds_raw[];
    LAS unsigned char* lds = (LAS unsigned char*)lds_raw;
    volatile LAS unsigned* MISC = (volatile LAS unsigned*)(lds + MISC_OFF);
    const int tid0 = threadIdx.x, G = gridDim.x;
#define LAUNDER_TID() int tid = tid0; asm volatile("" : "+v"(tid)); const int lane = tid & 63, wave = __builtin_amdgcn_readfirstlane(tid >> 6); const int gw = blockIdx.x * 8 + wave, NGW = G * 8; (void)lane; (void)gw; (void)NGW
    if (tid0 < 64) MISC[tid0] = 0u;
    __syncthreads();
    unsigned char* ws = args.ws;
    gu32* ctl = (gu32*)(ws + WS_CTL);
    XcdBarrier bar; bar.bar = (unsigned*)(ws + WS_CTL) + CW_BAR; bar.x = 0; bar.st = nullptr;
    if (MK_ONE_LAUNCH) bar = xcd_barrier_post((unsigned*)(ws + WS_CTL) + CW_BAR, MISC + 8);
#define GRID_BAR() do { if (MK_ONE_LAUNCH) xcd_barrier(bar); } while (0)
    const int lo = args.ph_lo, hi = args.ph_hi;
#define IN(k) (lo <= (k) && (k) < hi)
    const float* x = args.in[0]; float* out = args.out;
    pg8::ss_t* ss = (pg8::ss_t*)(ws + WS_SS);
    const float* cM = (const float*)(ws + WS_TAB + TAB_CM); const float* sM = (const float*)(ws + WS_TAB + TAB_SM);
    const float* cR = (const float*)(ws + WS_TAB + TAB_CR); const float* sR = (const float*)(ws + WS_TAB + TAB_SR); const float* lbt = (const float*)(ws + WS_TAB + TAB_LB);
    bf16_t* HB = (bf16_t*)(ws + WS_HB);
    unsigned char* act = ws + WS_ACT;
    bf16_t* Gb = (bf16_t*)act;
    bf16_t *QB = (bf16_t*)(act + A_QB), *KB = (bf16_t*)(act + A_KB), *VB = (bf16_t*)(act + A_VB), *CKV = (bf16_t*)(act + A_CKV), *RQ = (bf16_t*)(act + A_RQ), *RK = (bf16_t*)(act + A_RK),
           *RV = (bf16_t*)(act + A_RV), *RG = (bf16_t*)(act + A_RG), *HQ = (bf16_t*)(act + A_HQ), *HK = (bf16_t*)(act + A_HK), *HV = (bf16_t*)(act + A_HV), *HG = (bf16_t*)(act + A_HG),
           *CAT = (bf16_t*)(act + A_CAT);
    float* HLF = (float*)(act + A_HLF);

#ifndef NO_P0
    if (IN(0)) { asm volatile("; MARK_P0"); LAUNDER_TID();
        LAS float* scr = (LAS float*)(lds + wave * 16640);
        constexpr int I_UP = 32 * 88, I_DN = 88 * 32, I_IN = 32 * 97, I_KVB = 8 * 32, I_O = 32 * 32, I_LAYER = 6 * I_UP + I_IN + I_KVB + I_O;
        static_assert(I_UP == I_DN, "item counts");
        for (int it = gw; it < 4 * I_LAYER; it += NGW) {
            const int l = it / I_LAYER; int r = it - l * I_LAYER;
            unsigned char* wl = ws + WS_W + (size_t)l * W_LAYER;
            const float* W; const float* g; bf16_t* WT; int K, N, kind;
            if (r < 3 * I_UP) { const int w = r / I_UP; r -= w * I_UP;
                if (w == 0) { W = args.in[2] + (size_t)l * DM * DFF; g = args.in[1] + l * DM; WT = (bf16_t*)(wl + W_UP1); K = DM; N = DFF; kind = 1; }
                else if (w == 1) { W = args.in[3] + (size_t)l * DM * DFF; g = args.in[1] + l * DM; WT = (bf16_t*)(wl + W_UP1); K = DM; N = DFF; kind = 2; }
                else { W = args.in[4] + (size_t)l * DFF * DM; g = nullptr; WT = (bf16_t*)(wl + W_DN1); K = DFF; N = DM; kind = 0; } }
            else if ((r -= 3 * I_UP) < I_IN) { W = args.in[6] + (size_t)l * DM * DIN; g = args.in[5] + l * DM; WT = (bf16_t*)(wl + W_IN); K = DM; N = DIN; kind = 3; }
            else if ((r -= I_IN) < I_KVB) { W = args.in[8] + (size_t)l * KVR * 2048; g = args.in[7] + l * KVR; WT = (bf16_t*)(wl + W_KVB); K = KVR; N = 2048; kind = 0; }
            else if ((r -= I_KVB) < I_O) { W = args.in[13] + (size_t)l * DM * DM; g = nullptr; WT = (bf16_t*)(wl + W_O); K = DM; N = DM; kind = 0; }
            else { r -= I_O; const int w = r / I_UP; r -= w * I_UP;
                if (w == 0) { W = args.in[15] + (size_t)l * DM * DFF; g = args.in[14] + l * DM; WT = (bf16_t*)(wl + W_UP2); K = DM; N = DFF; kind = 1; }
                else if (w == 1) { W = args.in[16] + (size_t)l * DM * DFF; g = args.in[14] + l * DM; WT = (bf16_t*)(wl + W_UP2); K = DM; N = DFF; kind = 2; }
                else { W = args.in[17] + (size_t)l * DFF * DM; g = nullptr; WT = (bf16_t*)(wl + W_DN2); K = DFF; N = DM; kind = 0; } }
            tr_item(W, K, N, g, WT, kind, r, scr, lane);
        }
        { const int gt = blockIdx.x * 512 + tid, NT_ = G * 512;
          for (int i = gt; i < 4 * 49152; i += NT_) { const int l = i / 49152, r = i - l * 49152;
              *(u32x4*)(ws + WS_W + (size_t)l * W_LAYER + W_IN + (size_t)2112 * DM * 2 + (size_t)r * 16) = (u32x4){0u, 0u, 0u, 0u}; }
          float* cMw = (float*)(ws + WS_TAB + TAB_CM); float* sMw = (float*)(ws + WS_TAB + TAB_SM); float* cRw = (float*)(ws + WS_TAB + TAB_CR); float* sRw = (float*)(ws + WS_TAB + TAB_SR);
          for (int i = gt; i < SEQ * 32; i += NT_) { const int t = i >> 5, f = i & 31; double iv = 1.0; for (int k = 0; k < f; ++k) iv *= 0.7498942093324559;
              float s_, c_; sincos_d((float)t * (float)iv, s_, c_); cMw[i] = c_; sMw[i] = s_; }
          for (int i = gt; i < SEQ * 64; i += NT_) { const int t = i >> 6, f = i & 63; double iv = 1.0; for (int k = 0; k < f; ++k) iv *= 0.8659643233600653;
              float s_, c_; sincos_d((float)t * (float)iv, s_, c_); cRw[i] = c_; sRw[i] = s_; }
          float* lbw = (float*)(ws + WS_TAB + TAB_LB); const float* lg = args.in[11];
          for (int i = gt; i < 512; i += NT_) { const float x0 = lg[i], x1 = lg[512 + i], x2 = lg[1024 + i], x3 = lg[1536 + i], mx = fmaxf(fmaxf(x0, x1), fmaxf(x2, x3));
              const float e0 = __expf(x0 - mx), e1 = __expf(x1 - mx), e2 = __expf(x2 - mx), e3 = __expf(x3 - mx), inv = 1.f / (e0 + e1 + e2 + e3);
              lbw[i] = 0.f; lbw[512 + i] = e1 * inv; lbw[1024 + i] = (e1 + e2) * inv; lbw[1536 + i] = (e1 + e2 + e3) * inv; } }
        for (int m = gw; m < M; m += NGW) {
            const f32x4* xr = (const f32x4*)(x + (size_t)m * DM) + lane; f32x4 v[8]; float s = 0.f;
#pragma unroll
            for (int j = 0; j < 8; ++j) { v[j] = xr[64 * j]; s += (v[j][0] * v[j][0] + v[j][1] * v[j][1]) + (v[j][2] * v[j][2] + v[j][3] * v[j][3]); }
            s = wave_sum(s); if (lane == 0) ss[m] = (pg8::ss_t)(s * 1048576.f + 0.5f);
            u32x2* o8 = (u32x2*)(HB + (size_t)m * DM) + lane;
#pragma unroll
            for (int j = 0; j < 8; ++j) o8[64 * j] = (u32x2){cvtpk(v[j][0], v[j][1]), cvtpk(v[j][2], v[j][3])};
        }
        GRID_BAR();
    }
#endif

    for (int hl = 0; hl < 8; ++hl) {
        const int l = hl >> 1, second = hl & 1, pb = 1 + 6 * hl;
        unsigned char* wl = ws + WS_W + (size_t)l * W_LAYER;
        const pg8::ss_t* ss_in = ss + (size_t)(3 * l + (second ? 2 : 0)) * M;
        pg8::ss_t* ss_out = ss + (size_t)(3 * l + (second ? 3 : 1)) * M;
#ifndef NO_UP
        if (IN(pb)) { asm volatile("; MARK_UP");
            pg8::Gemm g{HB, (const bf16_t*)(wl + (second ? W_UP2 : W_UP1)), M, NUP, DM}; pg8::StaticOrder S; S.init(M, NUP, G, (int)blockIdx.x);
            pg8::EpiUp E{Gb, ss_in};
            pg8::gemm_phase<pg8::EpiUp, pg8::StaticOrder, true, true>(lds, g, S, E);
            GRID_BAR();
        }
#endif
#ifndef NO_DN
        if (IN(pb + 1)) { asm volatile("; MARK_DN");
            pg8::Gemm g{Gb, (const bf16_t*)(wl + (second ? W_DN2 : W_DN1)), M, DM, DFF}; pg8::StaticOrder S; S.init(M, DM, G, (int)blockIdx.x);
            pg8::EpiRes E{hl == 0 ? x : (const float*)out, out, HB, ss_out, ((ALPHA_MASK >> (3 * l + 2 * second)) & 1) ? 0.5f : 0.f};
            pg8::gemm_phase<pg8::EpiRes, pg8::StaticOrder, true, true>(lds, g, S, E);
            GRID_BAR();
        }
#endif
        if (!second) {
            pg8::ss_t* sskv = ss + (size_t)(13 + l) * M;
#ifndef NO_IN
            if (IN(pb + 2)) { asm volatile("; MARK_IN");
                pg8::Gemm g{HB, (const bf16_t*)(wl + W_IN), M, NIN, DM}; pg8::StaticOrder S; S.init(M, NIN, G, (int)blockIdx.x);
                pg8::EpiIn E{ss_out, sskv, cM, lbt + l * 512, QB, KB, CKV, RQ, HLF};
                pg8::gemm_phase<pg8::EpiIn, pg8::StaticOrder, true, true>(lds, g, S, E);
                GRID_BAR();
            }
#endif
#ifndef NO_KVB
            if (IN(pb + 3)) { asm volatile("; MARK_KVB");
                pg8::Gemm g{CKV, (const bf16_t*)(wl + W_KVB), M, 2048, KVR}; pg8::StaticOrder S; S.init(M, 2048, G, (int)blockIdx.x);
                pg8::EpiKvb E{sskv, KB, VB};
                pg8::gemm_phase<pg8::EpiKvb, pg8::StaticOrder, true, true>(lds, g, S, E);
                GRID_BAR();
            }
#endif
            if (IN(pb + 4)) { asm volatile("; MARK_MIX"); LAUNDER_TID();
#if defined(NO_SCAN) || defined(NO_ATT)
                { const int gt = blockIdx.x * 512 + tid, NT_ = G * 512;
#ifdef NO_ATT
                  for (int i = gt; i < M * 128; i += NT_) { const int row = i >> 7, c = i & 127; *(u32x4*)(CAT + (size_t)row * DM + c * 8) = (u32x4){0u, 0u, 0u, 0u}; }
#endif
#ifdef NO_SCAN
                  for (int i = gt; i < M * 128; i += NT_) { const int row = i >> 7, c = i & 127; *(u32x4*)(CAT + (size_t)row * DM + 1024 + c * 8) = (u32x4){0u, 0u, 0u, 0u}; }
#endif
                }
#endif
#ifndef NO_SCAN
                for (int it = blockIdx.x; it < 64; it += G) { const int type = it >> 5, bh = it & 31;
                    scan::scan_item(lds, type, bh >> 2, bh & 3, type ? HQ : RQ, type ? HK : RK, type ? HV : RV, type ? HG : RG, HLF, (type ? args.in[12] : args.in[10]) + l * 512, CAT, type ? 1536 : 1024); }
#endif
#ifndef NO_ATT
                asm volatile("; MARK_ATT");
                gu32* qh = ctl + CW_QHEAD + 64 * l;
                for (;;) {
                    if (tid == 0) MISC[16] = __hip_atomic_fetch_add(qh, 1u, RLX_AGENT);
                    __syncthreads();
                    const int it = __builtin_amdgcn_readfirstlane((int)MISC[16]);
                    __syncthreads();
                    if (it >= 512) break;
                    const int bh = it & 63;
                    att::attn_unit(lds, QB, KB, VB, CAT, args.in[9] + l * 1024, bh >> 3, bh & 7, 7 - (it >> 6));
                }
#endif
                GRID_BAR();
            }
#ifndef NO_OP
            if (IN(pb + 5)) { asm volatile("; MARK_OP");
                pg8::Gemm g{CAT, (const bf16_t*)(wl + W_O), M, DM, DM}; pg8::StaticOrder S; S.init(M, DM, G, (int)blockIdx.x);
                pg8::EpiRes E{(const float*)out, out, HB, ss + (size_t)(3 * l + 2) * M, ((ALPHA_MASK >> (3 * l + 1)) & 1) ? 1.0f : 0.f};
                pg8::gemm_phase<pg8::EpiRes, pg8::StaticOrder, true, true>(lds, g, S, E);
                GRID_BAR();
            }
#endif
        }
    }
    if (IN(49)) { asm volatile("; MARK_FIN"); LAUNDER_TID();
        const pg8::ss_t* ssf = ss + (size_t)12 * M; const f32x4* w4 = (const f32x4*)args.in[18] + lane;
        for (int m = gw; m < M; m += NGW) { const float rs = __builtin_amdgcn_rsqf(pg8::ss_get(ssf + m) * (1.f / DM) + EPS); f32x4* o = (f32x4*)(out + (size_t)m * DM) + lane;
#pragma unroll
            for (int j = 0; j < 8; ++j) o[64 * j] = o[64 * j] * rs * w4[64 * j]; }
    }
#undef IN
#undef GRID_BAR
}


#ifdef MK_CHECK
constexpr int CW_CHK = 12288;
__device__ __forceinline__ float bf2f(bf16_t v) { return __builtin_bit_cast(float, (unsigned)v << 16); }
__device__ __forceinline__ float rbf(float f) { unsigned u = __builtin_bit_cast(unsigned, f); u = (u + 0x7fffu + ((u >> 16) & 1u)) & 0xffff0000u; return __builtin_bit_cast(float, u); }
__device__ __forceinline__ unsigned hsh(unsigned x) { x ^= x >> 16; x *= 0x7feb352du; x ^= x >> 15; x *= 0x846ca68bu; x ^= x >> 16; return x; }
__device__ __forceinline__ void chk_cmp(unsigned* chk, int id, float got, float want, float rtol = 0.03f, float atol = 0.02f) {
    const float d = fabsf(got - want); if (!(d <= atol + rtol * fabsf(want))) atomicAdd(chk + id, 1u); }

__global__ void chk_prologue(Args a) {
    unsigned* chk = (unsigned*)(a.ws + WS_CTL) + CW_CHK; const unsigned i = blockIdx.x * blockDim.x + threadIdx.x; const unsigned h1 = hsh(i * 2 + 1), h2 = hsh(i * 2 + 2);
    unsigned char* wl = a.ws + WS_W;
    { const int k = h1 % DM, j = h2 % DFF; const float g = a.in[1][k];
      chk_cmp(chk, 0, bf2f(((bf16_t*)(wl + W_UP1))[(size_t)(256 * (j >> 7) + (j & 127)) * DM + k]), a.in[2][(size_t)k * DFF + j] * g, 0.01f, 1e-4f);
      chk_cmp(chk, 1, bf2f(((bf16_t*)(wl + W_UP1))[(size_t)(256 * (j >> 7) + (j & 127) + 128) * DM + k]), a.in[3][(size_t)k * DFF + j] * g, 0.01f, 1e-4f);
      chk_cmp(chk, 2, bf2f(((bf16_t*)(wl + W_DN1))[(size_t)k * DFF + j]), a.in[4][(size_t)j * DM + k], 0.01f, 1e-4f); }
    { const int k = h1 % DM, s = h2 % DIN; chk_cmp(chk, 3, bf2f(((bf16_t*)(wl + W_IN))[(size_t)map_in(s) * DM + k]), a.in[6][(size_t)k * DIN + s] * a.in[5][k], 0.01f, 1e-4f);
      const int zr = 2112 + (h2 % 192); chk_cmp(chk, 3, bf2f(((bf16_t*)(wl + W_IN))[(size_t)zr * DM + k]), 0.f, 0.f, 0.f); }
    { const int k = h1 % KVR, n = h2 % 2048; chk_cmp(chk, 4, bf2f(((bf16_t*)(wl + W_KVB))[(size_t)n * KVR + k]), a.in[8][(size_t)k * 2048 + n] * a.in[7][k], 0.01f, 1e-4f); }
    { const int k = h1 % DM, n = h2 % DM; chk_cmp(chk, 5, bf2f(((bf16_t*)(wl + W_O))[(size_t)n * DM + k]), a.in[13][(size_t)k * DM + n], 0.01f, 1e-4f); }
    { const int t = h1 % SEQ, f = h2 % 32; const float ang = (float)t * powf(10000.f, -(float)(2 * f) / 64.f);
      chk_cmp(chk, 6, ((const float*)(a.ws + WS_TAB + TAB_CM))[t * 32 + f], cosf(ang), 0.f, 2e-3f); chk_cmp(chk, 6, ((const float*)(a.ws + WS_TAB + TAB_SM))[t * 32 + f], sinf(ang), 0.f, 2e-3f); }
    { const int t = h1 % SEQ, f = h2 % 64; const float ang = (float)t * powf(10000.f, -(float)(2 * f) / 128.f);
      chk_cmp(chk, 7, ((const float*)(a.ws + WS_TAB + TAB_CR))[t * 64 + f], cosf(ang), 0.f, 2e-3f); chk_cmp(chk, 7, ((const float*)(a.ws + WS_TAB + TAB_SR))[t * 64 + f], sinf(ang), 0.f, 2e-3f); }
    { const int c = h1 % 512; const float* lg = a.in[11]; float e[4], s = 0.f;
#pragma unroll
      for (int l = 0; l < 4; ++l) { e[l] = expf(lg[l * 512 + c]); s += e[l]; }
      const float* lb = (const float*)(a.ws + WS_TAB + TAB_LB); chk_cmp(chk, 8, lb[c], 0.f, 0.f, 1e-6f); chk_cmp(chk, 8, lb[512 + c], e[1] / s, 0.001f, 1e-6f); chk_cmp(chk, 8, lb[1536 + c], (e[1] + e[2] + e[3]) / s, 0.001f, 1e-6f); }
    { const int m = h1 % M, c = h2 % DM; chk_cmp(chk, 9, bf2f(((bf16_t*)(a.ws + WS_HB))[(size_t)m * DM + c]), a.in[0][(size_t)m * DM + c], 0.01f, 1e-4f);
      if (i < 64) { float s = 0.f; for (int k = 0; k < DM; ++k) { const float v = a.in[0][(size_t)m * DM + k]; s += v * v; } chk_cmp(chk, 9, pg8::ss_get((const pg8::ss_t*)(a.ws + WS_SS) + m), s, 0.001f, 1e-3f); } }
}
__device__ __forceinline__ float dotbf(const bf16_t* A, size_t arow, const bf16_t* Bt, size_t brow, int K) { float s = 0.f; for (int k = 0; k < K; ++k) s += bf2f(A[arow * K + k]) * bf2f(Bt[brow * K + k]); return s; }
__global__ void chk_up(Args a, int hl) {
    unsigned* chk = (unsigned*)(a.ws + WS_CTL) + CW_CHK; const unsigned i = blockIdx.x * blockDim.x + threadIdx.x; const int m = hsh(i * 2 + 1) % M, j = hsh(i * 2 + 2) % DFF;
    const int l = hl >> 1, second = hl & 1; const bf16_t* HB = (const bf16_t*)(a.ws + WS_HB); const bf16_t* W = (const bf16_t*)(a.ws + WS_W + (size_t)l * W_LAYER + (second ? W_UP2 : W_UP1));
    const pg8::ss_t* ss = (const pg8::ss_t*)(a.ws + WS_SS) + (size_t)(3 * l + (second ? 2 : 0)) * M; const float rs = 1.f / sqrtf(pg8::ss_get(ss + m) / DM + EPS);
    const float g = rs * dotbf(HB, m, W, 256 * (j >> 7) + (j & 127), DM), u = rs * dotbf(HB, m, W, 256 * (j >> 7) + (j & 127) + 128, DM);
    chk_cmp(chk, 10, bf2f(((const bf16_t*)(a.ws + WS_ACT))[(size_t)m * DFF + j]), g / (1.f + expf(-g)) * u);
}
__global__ void chk_dn(Args a, int hl, const float* hprev  ) {
    unsigned* chk = (unsigned*)(a.ws + WS_CTL) + CW_CHK; const unsigned i = blockIdx.x * blockDim.x + threadIdx.x; const int m = hsh(i * 2 + 1) % M, c = hsh(i * 2 + 2) % DM;
    const int l = hl >> 1, second = hl & 1; const bf16_t* G = (const bf16_t*)(a.ws + WS_ACT); const bf16_t* W = (const bf16_t*)(a.ws + WS_W + (size_t)l * W_LAYER + (second ? W_DN2 : W_DN1));
    const float want = hprev[(size_t)m * DM + c] + 0.5f * dotbf(G, m, W, c, DFF);
    chk_cmp(chk, 11, a.out[(size_t)m * DM + c], want); chk_cmp(chk, 12, bf2f(((const bf16_t*)(a.ws + WS_HB))[(size_t)m * DM + c]), a.out[(size_t)m * DM + c], 0.01f, 1e-3f);
    if (i < 64) { float s = 0.f; for (int k = 0; k < DM; ++k) { const float v = a.out[(size_t)m * DM + k]; s += v * v; }
        chk_cmp(chk, 13, pg8::ss_get((const pg8::ss_t*)(a.ws + WS_SS) + (size_t)(3 * l + (second ? 3 : 1)) * M + m), s, 0.002f, 1e-2f); }
}
__global__ void chk_in(Args a, int l) {
    unsigned* chk = (unsigned*)(a.ws + WS_CTL) + CW_CHK; const unsigned i = blockIdx.x * blockDim.x + threadIdx.x; const int m = hsh(i * 2 + 1) % M, t = m & (SEQ - 1); const unsigned hh = hsh(i * 2 + 2);
    const bf16_t* HB = (const bf16_t*)(a.ws + WS_HB); const float* W = a.in[6] + (size_t)l * DM * DIN; const float* g = a.in[5] + l * DM;
    const pg8::ss_t* ss = (const pg8::ss_t*)(a.ws + WS_SS) + (size_t)(3 * l + 1) * M; const float rs = 1.f / sqrtf(pg8::ss_get(ss + m) / DM + EPS);
    unsigned char* act = a.ws + WS_ACT;
    auto proj = [&](int s) { float acc = 0.f; for (int k = 0; k < DM; ++k) acc += bf2f(HB[(size_t)m * DM + k]) * rbf(W[(size_t)k * DIN + s] * g[k]); return acc * rs; };
    const int sel = i % 12;
    if (sel == 0) { const int hd = hh % 8, d = (hh >> 8) % 128; chk_cmp(chk, 14, bf2f(((bf16_t*)(act + A_QB))[(size_t)m * 1536 + hd * 192 + d]), proj(hd * 192 + d) * QSCALE); }
    else if (sel == 1) { const int hd = hh % 8, f = (hh >> 8) % 32; const float x1 = proj(hd * 192 + 128 + f), x2 = proj(hd * 192 + 160 + f), ang = (float)t * powf(10000.f, -(float)(2 * f) / 64.f), c = cosf(ang), s = sinf(ang);
        chk_cmp(chk, 15, bf2f(((bf16_t*)(act + A_QB))[(size_t)m * 1536 + hd * 192 + 128 + 2 * f]), (x1 * c - x2 * s) * QSCALE); chk_cmp(chk, 15, bf2f(((bf16_t*)(act + A_QB))[(size_t)m * 1536 + hd * 192 + 128 + 2 * f + 1]), (x2 * c + x1 * s) * QSCALE); }
    else if (sel == 2) { const int c = hh % 512; chk_cmp(chk, 16, bf2f(((bf16_t*)(act + A_CKV))[(size_t)m * KVR + c]), proj(1536 + c));
        if (i < 48) { float s = 0.f; for (int k = 0; k < KVR; ++k) { const float v = bf2f(((bf16_t*)(act + A_CKV))[(size_t)m * KVR + k]); s += v * v; } chk_cmp(chk, 17, pg8::ss_get((const pg8::ss_t*)(a.ws + WS_SS) + (size_t)(13 + l) * M + m), s, 0.02f, 1e-2f); } }
    else if (sel == 3) { const int hd = hh % 8, f = (hh >> 8) % 32; const float x1 = proj(2048 + f), x2 = proj(2080 + f), ang = (float)t * powf(10000.f, -(float)(2 * f) / 64.f), c = cosf(ang), s = sinf(ang);
        chk_cmp(chk, 18, bf2f(((bf16_t*)(act + A_KB))[(size_t)m * 1536 + hd * 192 + 128 + 2 * f]), x1 * c - x2 * s); chk_cmp(chk, 18, bf2f(((bf16_t*)(act + A_KB))[(size_t)m * 1536 + hd * 192 + 128 + 2 * f + 1]), x2 * c + x1 * s); }
    else if (sel == 4 || sel == 5) { const int isk = sel == 5, hd = hh % 4, f = (hh >> 8) % 64, base = isk ? 2624 : 2112; const float sc = isk ? RKSCALE : 1.f;
        const float x1 = proj(base + hd * 128 + f), x2 = proj(base + hd * 128 + 64 + f), ang = (float)t * powf(10000.f, -(float)(2 * f) / 128.f), c = cosf(ang), s = sinf(ang);
        const bf16_t* B = (const bf16_t*)(act + (isk ? A_RK : A_RQ));
        chk_cmp(chk, 19 + isk, bf2f(B[(size_t)m * 512 + hd * 128 + 2 * f]), (x1 * c - x2 * s) * sc); chk_cmp(chk, 19 + isk, bf2f(B[(size_t)m * 512 + hd * 128 + 2 * f + 1]), (x2 * c + x1 * s) * sc); }
    else if (sel == 6) { const int c = hh % 512; chk_cmp(chk, 21, bf2f(((bf16_t*)(act + A_RV))[(size_t)m * 512 + c]), proj(3136 + c)); }
    else if (sel == 7) { const int c = hh % 512; const float v = proj(3648 + c); chk_cmp(chk, 22, bf2f(((bf16_t*)(act + A_RG))[(size_t)m * 512 + c]), v / (1.f + expf(-v))); }
    else if (sel == 8) { const int c = hh % 512; chk_cmp(chk, 23, bf2f(((bf16_t*)(act + A_HQ))[(size_t)m * 512 + c]), proj(4160 + c)); }
    else if (sel == 9) { const int c = hh % 512; const float z = proj(4672 + c), lbv = ((const float*)(a.ws + WS_TAB + TAB_LB))[l * 512 + c], sig = 1.f / (1.f + expf(-z)), f = lbv + (1.f - lbv) * sig;
        chk_cmp(chk, 24, ((const float*)(act + A_HLF))[(size_t)m * 512 + c], logf(fmaxf(f, 1e-20f)), 0.03f, 0.01f); chk_cmp(chk, 25, bf2f(((bf16_t*)(act + A_HK))[(size_t)m * 512 + c]), (1.f - lbv) * (1.f - sig), 0.03f, 0.01f); }
    else if (sel == 10) { const int c = hh % 512; chk_cmp(chk, 26, bf2f(((bf16_t*)(act + A_HV))[(size_t)m * 512 + c]), proj(5184 + c)); }
    else { const int c = hh % 512; const float v = proj(5696 + c); chk_cmp(chk, 27, bf2f(((bf16_t*)(act + A_HG))[(size_t)m * 512 + c]), v / (1.f + expf(-v))); }
}
__global__ void chk_kvb(Args a, int l) {
    unsigned* chk = (unsigned*)(a.ws + WS_CTL) + CW_CHK; const unsigned i = blockIdx.x * blockDim.x + threadIdx.x; const int m = hsh(i * 2 + 1) % M; const unsigned hh = hsh(i * 2 + 2); const int hd = hh % 8, d = (hh >> 8) % 128;
    unsigned char* act = a.ws + WS_ACT; const bf16_t* C = (const bf16_t*)(act + A_CKV); const bf16_t* W = (const bf16_t*)(a.ws + WS_W + (size_t)l * W_LAYER + W_KVB);
    const float rs2 = 1.f / sqrtf(pg8::ss_get((const pg8::ss_t*)(a.ws + WS_SS) + (size_t)(13 + l) * M + m) / KVR + EPS);
    chk_cmp(chk, 28, bf2f(((bf16_t*)(act + A_KB))[(size_t)m * 1536 + hd * 192 + d]), rs2 * dotbf(C, m, W, hd * 256 + d, KVR));
    chk_cmp(chk, 29, bf2f(((bf16_t*)(act + A_VB))[(size_t)m * 1024 + hd * 128 + d]), rs2 * dotbf(C, m, W, hd * 256 + 128 + d, KVR));
}
__global__ void chk_attn(Args a, int l) {
    unsigned* chk = (unsigned*)(a.ws + WS_CTL) + CW_CHK; __shared__ float red[128];
    const unsigned hh = hsh(blockIdx.x * 7 + 3); const int b = hh % 8, h = (hh >> 3) % 8; int t = (hh >> 8) % SEQ; if (blockIdx.x < 8) t = (blockIdx.x & 1) ? 255 + 256 * (blockIdx.x >> 1) : 256 * (blockIdx.x >> 1);
    const int e = threadIdx.x; unsigned char* act = a.ws + WS_ACT; const bf16_t* Q = (const bf16_t*)(act + A_QB) + ((size_t)(b * SEQ + t) * 1536 + h * 192);
    const bf16_t* K = (const bf16_t*)(act + A_KB) + (size_t)b * SEQ * 1536 + h * 192; const bf16_t* V = (const bf16_t*)(act + A_VB) + (size_t)b * SEQ * 1024 + h * 128 + e;
    float mx = -1e30f; for (int j = 0; j <= t; ++j) { float s = 0.f; for (int d = 0; d < 192; ++d) s += bf2f(Q[d]) * bf2f(K[(size_t)j * 1536 + d]); mx = fmaxf(mx, s); }
    float den = 0.f, num = 0.f; for (int j = 0; j <= t; ++j) { float s = 0.f; for (int d = 0; d < 192; ++d) s += bf2f(Q[d]) * bf2f(K[(size_t)j * 1536 + d]); const float p = exp2f(s - mx); den += p; num += p * bf2f(V[(size_t)j * 1024]); }
    const float o = num / den; red[e] = o * o; __syncthreads(); for (int s = 64; s > 0; s >>= 1) { if (e < s) red[e] += red[e + s]; __syncthreads(); }
    const float want = o / sqrtf(red[0] / 128.f + EPS) * a.in[9][l * 1024 + h * 128 + e];
    chk_cmp(chk, 30, bf2f(((bf16_t*)(act + A_CAT))[(size_t)(b * SEQ + t) * DM + h * 128 + e]), want, 0.1f, 0.1f);
}
__global__ void __launch_bounds__(512) chk_scan(Args a, int l) {
    unsigned* chk = (unsigned*)(a.ws + WS_CTL) + CW_CHK; __shared__ float red[4][128]; __shared__ float ov[128]; constexpr int NTOK = 200;
    const int type = blockIdx.x & 1, b = (blockIdx.x >> 1) % 8, h = (blockIdx.x * 5 + 1) % 4, e = threadIdx.x & 127, dg = threadIdx.x >> 7; unsigned char* act = a.ws + WS_ACT;
    const bf16_t* Qg = (const bf16_t*)(act + (type ? A_HQ : A_RQ)); const bf16_t* Kg = (const bf16_t*)(act + (type ? A_HK : A_RK)); const bf16_t* Vg = (const bf16_t*)(act + (type ? A_HV : A_RV));
    const bf16_t* Gg = (const bf16_t*)(act + (type ? A_HG : A_RG)); const float* LF = (const float*)(act + A_HLF); const float* nw = (type ? a.in[12] : a.in[10]) + l * 512;
    const float gam = 1.f - 1.f / (float)(32 << h);
    float S[32];
#pragma unroll
    for (int d = 0; d < 32; ++d) S[d] = 0.f;
    for (int t = 0; t < NTOK; ++t) { const size_t ro = ((size_t)(b * SEQ + t)) * 512 + h * 128; const float v = bf2f(Vg[ro + e]); float o = 0.f;
#pragma unroll
        for (int d = 0; d < 32; ++d) { const int dd = 32 * dg + d; const float f = type ? __expf(LF[ro + dd]) : gam; S[d] = f * S[d] + bf2f(Kg[ro + dd]) * v; o += bf2f(Qg[ro + dd]) * S[d]; }
        red[dg][e] = o; __syncthreads(); o = red[0][e] + red[1][e] + red[2][e] + red[3][e]; if (dg == 0) ov[e] = o; __syncthreads();
        float s1 = 0.f; for (int d = 0; d < 128; ++d) s1 += ov[d]; const float mu = type ? 0.f : s1 / 128.f;
        float s2 = 0.f; for (int d = 0; d < 128; ++d) s2 += (ov[d] - mu) * (ov[d] - mu);
        const float want = (o - mu) / sqrtf(s2 / 128.f + EPS) * nw[h * 128 + e] * bf2f(Gg[ro + e]);
        if (dg == 0) chk_cmp(chk, 31 + type, bf2f(((bf16_t*)(act + A_CAT))[(size_t)(b * SEQ + t) * DM + 1024 + type * 512 + h * 128 + e]), want, 0.1f, 0.1f);
        __syncthreads(); }
}
__global__ void chk_op(Args a, int l, const float* hprev) {
    unsigned* chk = (unsigned*)(a.ws + WS_CTL) + CW_CHK; const unsigned i = blockIdx.x * blockDim.x + threadIdx.x; const int m = hsh(i * 2 + 1) % M, c = hsh(i * 2 + 2) % DM;
    const float want = hprev[(size_t)m * DM + c] + dotbf((const bf16_t*)(a.ws + WS_ACT + A_CAT), m, (const bf16_t*)(a.ws + WS_W + (size_t)l * W_LAYER + W_O), c, DM);
    chk_cmp(chk, 33, a.out[(size_t)m * DM + c], want);
}
__global__ void chk_report(Args a) {
    const unsigned* chk = (const unsigned*)(a.ws + WS_CTL) + CW_CHK; int first = -1; for (int i = 0; i < 64; ++i) if (chk[i] && first < 0) first = i;
    if (first < 0) return; const float c = sqrtf(0.1f * (float)(first + 1));
    for (size_t i = blockIdx.x * (size_t)blockDim.x + threadIdx.x; i < (size_t)M * DM; i += (size_t)gridDim.x * blockDim.x) a.out[i] = c;
}
#endif
extern "C" void kernel_launch(void* const* d_in, const int* in_sizes, int n_in, void* d_out, int out_size, void* d_ws, size_t ws_size, hipStream_t stream) {
    static int grid = 0;
    if (grid == 0) {
        if (n_in != 19 || in_sizes[0] != M * DM || out_size != M * DM || ws_size < WS_END) {
            fprintf(stderr, "kernel_launch: built for 19 inputs, x and out of %d floats, >= %zu bytes of workspace; got n_in %d, in0 %d, out %d, ws %zu; nothing launched\n", M * DM, (size_t)WS_END, n_in, n_in > 0 ? in_sizes[0] : -1, out_size, ws_size);
            grid = -1; return; }
        int dev = 0, cus = 0, per_cu = 0;
        if (hipGetDevice(&dev) != hipSuccess || hipDeviceGetAttribute(&cus, hipDeviceAttributeMultiprocessorCount, dev) != hipSuccess) { fprintf(stderr, "kernel_launch: device query failed\n"); grid = -1; return; }
        if (hipFuncSetAttribute((const void*)mk_fwd, hipFuncAttributeMaxDynamicSharedMemorySize, LDS_BYTES) != hipSuccess) { fprintf(stderr, "kernel_launch: hipFuncSetAttribute failed\n"); grid = -1; return; }
        if (hipOccupancyMaxActiveBlocksPerMultiprocessor(&per_cu, (const void*)mk_fwd, 512, LDS_BYTES) != hipSuccess || per_cu < 1) {
            fprintf(stderr, "kernel_launch: occupancy query reports %d workgroups per CU\n", per_cu); (void)hipGetLastError(); per_cu = 1; }
        grid = cus;
    }
    if (grid < 0) return;
    if (hipMemsetAsync((char*)d_ws + WS_CTL, 0, CTL_ZERO_BYTES, stream) != hipSuccess) { fprintf(stderr, "kernel_launch: memset failed\n"); return; }
    Args a{};
    for (int i = 0; i < 19; ++i) a.in[i] = (const float*)d_in[i];
    a.out = (float*)d_out; a.ws = (unsigned char*)d_ws;
#if MK_ONE_LAUNCH
    a.ph_lo = 0; a.ph_hi = NPH;
    hipLaunchKernelGGL(mk_fwd, dim3(grid), dim3(512), LDS_BYTES, stream, a);
    { const hipError_t le = hipPeekAtLastError(); if (le != hipSuccess) fprintf(stderr, "kernel_launch: launch failed: %s\n", hipGetErrorName(le)); }
#else
    for (int ph = 0; ph < NPH; ++ph) {
        if (ph >= 1 && ph < 49) { const int hl = (ph - 1) / 6, p = (ph - 1) % 6; if ((hl & 1) && p >= 2) continue; }
        a.ph_lo = ph; a.ph_hi = ph + 1;
#ifdef MK_CHECK
        float* hprev = (float*)((unsigned char*)d_ws + WS_END);
        if (ph == 6) (void)hipMemcpyAsync(hprev, d_out, (size_t)M * DM * 4, hipMemcpyDeviceToDevice, stream);
#endif
        hipLaunchKernelGGL(mk_fwd, dim3(grid), dim3(512), LDS_BYTES, stream, a);
        const hipError_t le = hipPeekAtLastError(); if (le != hipSuccess) { fprintf(stderr, "kernel_launch: launch of phase %d failed: %s\n", ph, hipGetErrorName(le)); break; }
#ifdef MK_CHECK
        if (ph == 0) hipLaunchKernelGGL(chk_prologue, dim3(64), dim3(256), 0, stream, a);
        if (ph == 1) hipLaunchKernelGGL(chk_up, dim3(4), dim3(256), 0, stream, a, 0);
        if (ph == 2) hipLaunchKernelGGL(chk_dn, dim3(4), dim3(256), 0, stream, a, 0, (const float*)d_in[0]);
        if (ph == 3) hipLaunchKernelGGL(chk_in, dim3(8), dim3(256), 0, stream, a, 0);
        if (ph == 4) hipLaunchKernelGGL(chk_kvb, dim3(4), dim3(256), 0, stream, a, 0);
        if (ph == 5) { hipLaunchKernelGGL(chk_attn, dim3(24), dim3(128), 0, stream, a, 0); hipLaunchKernelGGL(chk_scan, dim3(8), dim3(512), 0, stream, a, 0); }
        if (ph == 6) hipLaunchKernelGGL(chk_op, dim3(4), dim3(256), 0, stream, a, 0, (const float*)hprev);
        if (ph == NPH - 1) hipLaunchKernelGGL(chk_report, dim3(1024), dim3(256), 0, stream, a);
#endif
    }
#endif
}
```

```cpp
#include <hip/hip_runtime.h>
#include <cstdio>
#include <cstdint>

#ifndef MK_ONE_LAUNCH
#define MK_ONE_LAUNCH 1
#endif

constexpr int BATCH = 8, SEQ = 2048, DM = 2048, DEPTH = 4, DFF = 5632, DIN = 6208, KVR = 512;
constexpr int M = BATCH * SEQ;
constexpr int NUP = 2 * DFF;
constexpr int NIN = 6400;
constexpr float EPS = 1e-6f;
constexpr float QSCALE = 0.10411755f;
constexpr float RKSCALE = 0.08838834764831845f;
constexpr float LOG2E = 1.4426950408889634f;

namespace pg8 {
#define PG8_LAS __attribute__((address_space(3)))
typedef unsigned short bf16_t;
typedef short bf16x8 __attribute__((ext_vector_type(8)));
typedef float f32x4 __attribute__((ext_vector_type(4)));
typedef unsigned u32x4 __attribute__((ext_vector_type(4)));
constexpr int BM = 256, BK = 64, HALF = 128, HTB = HALF * BK * 2  , STAGE_BYTES = 8 * HTB, NXCD = 8, WGM = 8;

__host__ __device__ __forceinline__ int lds_byte(int r, int c) { const int st = (r >> 4) * 2 + (c >> 5), rr = r & 15, cc = c & 31, ob = rr * 64 + cc * 2; return st * 1024 + (ob ^ (((ob >> 9) & 1) << 5)); }
__host__ __device__ __forceinline__ void stage_rc(int b, int& R, int& C) { const int st = b / 1024, sb = b % 1024, swz = sb ^ (((sb >> 9) & 1) << 5); R = (st >> 1) * 16 + swz / 64; C = (st & 1) * 32 + (swz % 64) / 2; }
__host__ __device__ __forceinline__ int perm32(int rho) { const int n = rho >> 4, i = rho & 15; return 8 * (i >> 2) + 4 * n + (i & 3); }

struct Unit { int pm, pn; };
struct Gemm { const bf16_t* A; const bf16_t* Bt; int M, N, K; };

struct StaticOrder {
    int nM, nN, nwg, G, c;
    __host__ __device__ void init(int M, int N, int G_, int c_) { nM = M / BM; nN = N / BM; nwg = nM * nN; G = G_; c = c_; }
    __host__ __device__ bool next(int i, Unit& u) const {
        const long L = (long)i * G + c; if (L >= nwg) return false;
        int wgid = (int)L; { const int q = nwg / NXCD, r = nwg % NXCD, xcd = wgid % NXCD, off = wgid / NXCD; wgid = (xcd < r ? xcd * (q + 1) : r * (q + 1) + (xcd - r) * q) + off; }
        const int nig = WGM * nN, gid = wgid / nig, fm = gid * WGM, gsz = (nM - fm) < WGM ? (nM - fm) : WGM;
        u.pm = fm + ((wgid % nig) % gsz); u.pn = (wgid % nig) / gsz; return true;
    }
    __device__ __forceinline__ void a_ready(const Unit&) const {}
    __device__ __forceinline__ void done(const Unit&) const {}
};

__device__ __forceinline__ unsigned cvt_pk_bf16(float lo, float hi) { unsigned r; asm volatile("v_cvt_pk_bf16_f32 %0, %1, %2" : "=v"(r) : "v"(lo), "v"(hi)); return r; }
typedef float f32x2 __attribute__((ext_vector_type(2)));

typedef unsigned u32x2 __attribute__((ext_vector_type(2)));
typedef unsigned long long ss_t;
__device__ __forceinline__ float ss_get(const ss_t* p) { return (float)(*p) * (1.f / 1048576.f); }
__device__ __forceinline__ void ss_add(ss_t* p, float part) { atomicAdd(p, (ss_t)(part * 1048576.f + 0.5f)); }
__device__ __forceinline__ float ex2(float x) { return __builtin_amdgcn_exp2f(x); }
__device__ __forceinline__ float rcpf_(float x) { return __builtin_amdgcn_rcpf(x); }
__device__ __forceinline__ float rsq(float x) { return __builtin_amdgcn_rsqf(x); }
__device__ __forceinline__ float siluf_(float x) { return x * rcpf_(1.f + ex2(-x * LOG2E)); }
__device__ __forceinline__ u32x4 pack8f(const float (&o)[8]) { u32x4 w; w.x = cvt_pk_bf16(o[0], o[1]); w.y = cvt_pk_bf16(o[2], o[3]); w.z = cvt_pk_bf16(o[4], o[5]); w.w = cvt_pk_bf16(o[6], o[7]); return w; }
__device__ __forceinline__ void rope8(float (&v)[8], const f32x4 c, const f32x4 s) {
#pragma unroll
    for (int q = 0; q < 4; ++q) { const float a = v[2 * q], b = v[2 * q + 1]; v[2 * q] = a * c[q] - b * s[q]; v[2 * q + 1] = b * c[q] + a * s[q]; }
}
#define AT(T, base, byteoff) ((T*)((char*)(base) + (unsigned)(byteoff)))
#define EPI_FENCE() do { asm volatile("" ::: "memory"); __builtin_amdgcn_sched_barrier(0); } while (0)
#define EPI_V8(v, ai, bj, m, sc) do { _Pragma("unroll") for (int n_ = 0; n_ < 2; ++n_) _Pragma("unroll") for (int j_ = 0; j_ < 4; ++j_) v[4 * n_ + j_] = acc[ai][bj][m][n_][j_] * (sc); } while (0)

struct EpiUp {
    static constexpr bool PERM = true, AFTER_DRAIN = false, IDEMPOTENT = true;
    bf16_t* G; const ss_t* ss;
    __device__ __forceinline__ void operator()(const f32x4 (&acc)[2][2][4][2], const Unit& u, int wr, int wc, int fr, int fq) const {
        asm volatile("" : "+v"(fr), "+v"(fq));
        const int row0 = u.pm * BM + wr * 64 + fr, col0 = u.pn * HALF + wc * 32 + 8 * fq;
        float rsv[2][4];
#pragma unroll
        for (int ai = 0; ai < 2; ++ai)
#pragma unroll
            for (int m = 0; m < 4; ++m) rsv[ai][m] = ss_get(AT(const ss_t, ss, (row0 + ai * HALF + m * 16) * 8u));
#pragma unroll
        for (int ai = 0; ai < 2; ++ai)
#pragma unroll
            for (int m = 0; m < 4; ++m) { const int row = row0 + ai * HALF + m * 16; const float rs = rsq(rsv[ai][m] * (1.f / DM) + EPS);
                float g[8], up[8], o[8]; EPI_V8(g, ai, 0, m, rs); EPI_V8(up, ai, 1, m, rs);
#pragma unroll
                for (int i = 0; i < 8; ++i) o[i] = siluf_(g[i]) * up[i];
                *AT(u32x4, G, (unsigned)row * (DFF * 2u) + col0 * 2u) = pack8f(o); EPI_FENCE(); }
    }
};

struct EpiRes {
    static constexpr bool PERM = true, AFTER_DRAIN = false, IDEMPOTENT = false;
    bf16_t* hb; ss_t* ssn; float alpha;
    __device__ __forceinline__ void operator()(const f32x4 (&acc)[2][2][4][2], const Unit& u, int wr, int wc, int fr, int fq) const {
        asm volatile("" : "+v"(fr), "+v"(fq));
        const int row0 = u.pm * BM + wr * 64 + fr, col0 = u.pn * BM + wc * 32 + 8 * fq;
        u32x4 sa[2][2], sb[2][2];
#define RES_LOAD(buf, ai, mp) do { _Pragma("unroll") for (int mm = 0; mm < 2; ++mm) _Pragma("unroll") for (int bj = 0; bj < 2; ++bj) \
            buf[mm][bj] = *AT(const u32x4, hb, ((unsigned)(row0 + (ai) * HALF + (2 * (mp) + mm) * 16) * DM + col0 + bj * HALF) * 2u); } while (0)
#define RES_PROC(buf, ai, mp) do { _Pragma("unroll") for (int mm = 0; mm < 2; ++mm) { const int m = 2 * (mp) + mm, row = row0 + (ai) * HALF + m * 16; float part = 0.f; \
            _Pragma("unroll") for (int bj = 0; bj < 2; ++bj) { const unsigned off = (unsigned)row * DM + col0 + bj * HALF; const u32x4 h4 = buf[mm][bj]; \
                const f32x4 r0 = {__builtin_bit_cast(float, h4.x << 16), __builtin_bit_cast(float, h4.x & 0xffff0000u), __builtin_bit_cast(float, h4.y << 16), __builtin_bit_cast(float, h4.y & 0xffff0000u)}; \
                const f32x4 r1 = {__builtin_bit_cast(float, h4.z << 16), __builtin_bit_cast(float, h4.z & 0xffff0000u), __builtin_bit_cast(float, h4.w << 16), __builtin_bit_cast(float, h4.w & 0xffff0000u)}; \
                const f32x4 o0 = r0 + acc[ai][bj][m][0] * alpha, o1 = r1 + acc[ai][bj][m][1] * alpha; \
                part += (o0[0] * o0[0] + o0[1] * o0[1]) + (o0[2] * o0[2] + o0[3] * o0[3]) + (o1[0] * o1[0] + o1[1] * o1[1]) + (o1[2] * o1[2] + o1[3] * o1[3]); \
                u32x4 w; w.x = cvt_pk_bf16(o0[0], o0[1]); w.y = cvt_pk_bf16(o0[2], o0[3]); w.z = cvt_pk_bf16(o1[0], o1[1]); w.w = cvt_pk_bf16(o1[2], o1[3]); \
                *AT(u32x4, hb, off * 2u) = w; } \
            part += __shfl_xor(part, 16); part += __shfl_xor(part, 32); \
            if (fq == 0) ss_add(AT(ss_t, ssn, row * 8u), part); } EPI_FENCE(); } while (0)
        RES_LOAD(sa, 0, 0);
        RES_LOAD(sb, 0, 1); RES_PROC(sa, 0, 0);
        RES_LOAD(sa, 1, 0); RES_PROC(sb, 0, 1);
        RES_LOAD(sb, 1, 1); RES_PROC(sa, 1, 0);
        RES_PROC(sb, 1, 1);
#undef RES_LOAD
#undef RES_PROC
    }
};

struct EpiIn {
    static constexpr bool PERM = true, AFTER_DRAIN = false, IDEMPOTENT = false;
    const ss_t* ss; ss_t* sskv; const float* tab; const float* lb;
    bf16_t *QB, *KB, *CKV, *XB; float* HLF;
    __device__ __forceinline__ void operator()(const f32x4 (&acc)[2][2][4][2], const Unit& u, int wr, int wc, int fr, int fq) const {
        asm volatile("" : "+v"(fr), "+v"(fq));
        const int row0 = u.pm * BM + wr * 64 + fr, pn = u.pn, cw = wc * 32 + 8 * fq;
        const float* cM = tab; const float* sM = tab + 65536; const float* cR = tab + 131072; const float* sR = tab + 262144;
        bf16_t* xb = XB + (size_t)((pn - 9) >> 1) * ((size_t)M * 512);
        float rs[2][4];
#pragma unroll
        for (int ai = 0; ai < 2; ++ai)
#pragma unroll
            for (int m = 0; m < 4; ++m) rs[ai][m] = rsq(ss_get(AT(const ss_t, ss, (row0 + ai * HALF + m * 16) * 8u)) * (1.f / DM) + EPS);
        if (pn < 4) {
#pragma unroll
            for (int ai = 0; ai < 2; ++ai)
#pragma unroll
                for (int m = 0; m < 4; ++m) { const int row = row0 + ai * HALF + m * 16;
#pragma unroll
                    for (int bj = 0; bj < 2; ++bj) { float v[8]; EPI_V8(v, ai, bj, m, rs[ai][m] * QSCALE);
                        *AT(u32x4, QB, (unsigned)row * 3072u + ((2 * pn + bj) * 192 + cw) * 2u) = pack8f(v); } EPI_FENCE(); }
        } else if (pn < 6) {
#pragma unroll
            for (int bj = 0; bj < 2; ++bj) { const int e0 = 256 * (pn - 4) + HALF * bj + cw, head = e0 >> 6, p0 = e0 & 63, i0 = p0 >> 1;
#pragma unroll
                for (int ai = 0; ai < 2; ++ai)
#pragma unroll
                    for (int m = 0; m < 4; ++m) { const int row = row0 + ai * HALF + m * 16, t = row & (SEQ - 1);
                        const f32x4 c4 = *AT(const f32x4, cM, (t * 32 + i0) * 4u), s4 = *AT(const f32x4, sM, (t * 32 + i0) * 4u);
                        float v[8]; EPI_V8(v, ai, bj, m, rs[ai][m] * QSCALE); rope8(v, c4, s4);
                        *AT(u32x4, QB, (unsigned)row * 3072u + (head * 192 + 128 + p0) * 2u) = pack8f(v); EPI_FENCE(); } }
        } else if (pn < 8) {
#pragma unroll
            for (int ai = 0; ai < 2; ++ai)
#pragma unroll
                for (int m = 0; m < 4; ++m) { const int row = row0 + ai * HALF + m * 16; float part = 0.f;
#pragma unroll
                    for (int bj = 0; bj < 2; ++bj) { float v[8]; EPI_V8(v, ai, bj, m, rs[ai][m]);
#pragma unroll
                        for (int i = 0; i < 8; ++i) part += v[i] * v[i];
                        *AT(u32x4, CKV, (unsigned)row * (KVR * 2u) + (256 * (pn - 6) + HALF * bj + cw) * 2u) = pack8f(v); }
                    part += __shfl_xor(part, 16); part += __shfl_xor(part, 32);
                    if (fq == 0) ss_add(AT(ss_t, sskv, row * 8u), part); EPI_FENCE(); }
        } else if (pn == 8) {
            if (wc < 2) { const int p0 = cw, i0 = p0 >> 1;
#pragma unroll
                for (int ai = 0; ai < 2; ++ai)
#pragma unroll
                    for (int m = 0; m < 4; ++m) { const int row = row0 + ai * HALF + m * 16, t = row & (SEQ - 1);
                        const f32x4 c4 = *AT(const f32x4, cM, (t * 32 + i0) * 4u), s4 = *AT(const f32x4, sM, (t * 32 + i0) * 4u);
                        float v[8]; EPI_V8(v, ai, 0, m, rs[ai][m]); rope8(v, c4, s4); const u32x4 w = pack8f(v);
#pragma unroll
                        for (int hd = 0; hd < 8; ++hd) *AT(u32x4, KB, (unsigned)row * 3072u + (hd * 192 + 128 + p0) * 2u) = w; EPI_FENCE(); } }
        } else if (pn < 13) {
            const bool isk = pn >= 11; bf16_t* dstb = xb; const float sc = isk ? RKSCALE : 1.f; const int pp = pn - (isk ? 11 : 9), i0 = cw >> 1;
#pragma unroll
            for (int bj = 0; bj < 2; ++bj)
#pragma unroll
                for (int ai = 0; ai < 2; ++ai)
#pragma unroll
                    for (int m = 0; m < 4; ++m) { const int row = row0 + ai * HALF + m * 16, t = row & (SEQ - 1);
                        const f32x4 c4 = *AT(const f32x4, cR, (t * 64 + i0) * 4u), s4 = *AT(const f32x4, sR, (t * 64 + i0) * 4u);
                        float v[8]; EPI_V8(v, ai, bj, m, rs[ai][m] * sc); rope8(v, c4, s4);
                        *AT(u32x4, dstb, (unsigned)row * 1024u + ((2 * pp + bj) * 128 + cw) * 2u) = pack8f(v); EPI_FENCE(); }
        } else if (pn == 19 || pn == 20) {
#pragma unroll
            for (int bj = 0; bj < 2; ++bj) { const int col = 256 * (pn - 19) + HALF * bj + cw;
                const f32x4 l0 = *AT(const f32x4, lb, col * 4u), l1 = *AT(const f32x4, lb, col * 4u + 16u); const float lbv[8] = {l0[0], l0[1], l0[2], l0[3], l1[0], l1[1], l1[2], l1[3]};
#pragma unroll
                for (int ai = 0; ai < 2; ++ai)
#pragma unroll
                    for (int m = 0; m < 4; ++m) { const int row = row0 + ai * HALF + m * 16; float z[8], lf[8], kk[8]; EPI_V8(z, ai, bj, m, rs[ai][m]);
#pragma unroll
                        for (int i = 0; i < 8; ++i) { const float zc = fminf(fmaxf(z[i], -60.f), 60.f), e = ex2(-zc * LOG2E), sig = rcpf_(1.f + e), nsig = e * sig, om = 1.f - lbv[i];
                            const float f = lbv[i] + om * sig; lf[i] = __builtin_amdgcn_logf(fmaxf(f, 1e-20f)) * 0.6931471805599453f; kk[i] = om * nsig; }
                        const unsigned lo_ = (unsigned)row * 2048u + col * 4u; *AT(f32x4, HLF, lo_) = (f32x4){lf[0], lf[1], lf[2], lf[3]}; *AT(f32x4, HLF, lo_ + 16u) = (f32x4){lf[4], lf[5], lf[6], lf[7]};
                        *AT(u32x4, xb, (unsigned)row * 1024u + col * 2u) = pack8f(kk); EPI_FENCE(); } }
        } else {
            bf16_t* dstb = xb; const bool act = (pn == 15 || pn == 16 || pn >= 23); const int cb = 256 * ((pn + 1) & 1);
#pragma unroll
            for (int ai = 0; ai < 2; ++ai)
#pragma unroll
                for (int m = 0; m < 4; ++m) { const int row = row0 + ai * HALF + m * 16;
#pragma unroll
                    for (int bj = 0; bj < 2; ++bj) { float v[8]; EPI_V8(v, ai, bj, m, rs[ai][m]);
                        if (act) {
#pragma unroll
                            for (int i = 0; i < 8; ++i) v[i] = siluf_(v[i]); }
                        *AT(u32x4, dstb, (unsigned)row * 1024u + (cb + HALF * bj + cw) * 2u) = pack8f(v); } EPI_FENCE(); }
        }
    }
};

struct EpiKvb {
    static constexpr bool PERM = true, AFTER_DRAIN = false, IDEMPOTENT = false;
    const ss_t* sskv; bf16_t* KB; bf16_t* VB;
    __device__ __forceinline__ void operator()(const f32x4 (&acc)[2][2][4][2], const Unit& u, int wr, int wc, int fr, int fq) const {
        asm volatile("" : "+v"(fr), "+v"(fq));
        const int row0 = u.pm * BM + wr * 64 + fr, head = u.pn, cw = wc * 32 + 8 * fq;
        float rsv[2][4];
#pragma unroll
        for (int ai = 0; ai < 2; ++ai)
#pragma unroll
            for (int m = 0; m < 4; ++m) rsv[ai][m] = ss_get(AT(const ss_t, sskv, (row0 + ai * HALF + m * 16) * 8u));
#pragma unroll
        for (int ai = 0; ai < 2; ++ai)
#pragma unroll
            for (int m = 0; m < 4; ++m) { const int row = row0 + ai * HALF + m * 16; const float rs2 = rsq(rsv[ai][m] * (1.f / KVR) + EPS);
                float v[8]; EPI_V8(v, ai, 0, m, rs2); *AT(u32x4, KB, (unsigned)row * 3072u + (head * 192 + cw) * 2u) = pack8f(v);
                EPI_V8(v, ai, 1, m, rs2); *AT(u32x4, VB, (unsigned)row * 2048u + (head * 128 + cw) * 2u) = pack8f(v); EPI_FENCE(); }
    }
};

template <class Epi, class Sched, bool ALIGN_EPI = false, bool SP2 = false>
__device__ __forceinline__ void gemm_phase(PG8_LAS unsigned char* lds, const Gemm g, const Sched& S, const Epi& E) {
    int tid_ = threadIdx.x; asm volatile("" : "+v"(tid_));
    const int tid = tid_, wid = __builtin_amdgcn_readfirstlane(tid >> 6), lane = tid & 63, wr = wid >> 2, wc = wid & 3, fr = lane & 15, fq = lane >> 4;
    const int K = g.K, nt = K / BK;
    unsigned voffA[2], voffB[2];
#pragma unroll
    for (int i = 0; i < 2; ++i) { int R, C; stage_rc(tid * 16 + i * 8192, R, C); const int Rb = Epi::PERM ? ((R & ~31) + perm32(R & 31)) : R;
        voffA[i] = (unsigned)(R * K + C) * 2u; voffB[i] = (unsigned)(Rb * K + C) * 2u; }
    const size_t kstep = (size_t)(BK * 2);
    const size_t hstep = (size_t)HALF * K * 2;
    const size_t tstep = 2 * hstep;
    const unsigned ldsw = (unsigned)wid * 1024u;
    const int aoff = lds_byte(wr * 64 + fr, fq * 8), boff = lds_byte(wc * 32 + fr, fq * 8);
#define PG8_SA(b, h) (((b) * 2 + (h)) * HTB)
#define PG8_SB(b, h) ((4 + (b) * 2 + (h)) * HTB)
#define PG8_STAGE(bufoff, gbase, voff) do { _Pragma("unroll") for (int _i = 0; _i < 2; ++_i) \
        __builtin_amdgcn_global_load_lds((const unsigned*)((const char*)(gbase) + (voff)[_i]), (PG8_LAS unsigned*)(lds + (bufoff) + ldsw + _i * 8192), 16, 0, 0); } while (0)
#define PG8_LDA(dst, b, h) do { _Pragma("unroll") for (int m = 0; m < 4; ++m) _Pragma("unroll") for (int k = 0; k < 2; ++k) dst[m][k] = *(const PG8_LAS bf16x8*)(lds + PG8_SA(b, h) + aoff + m * 2048 + k * 1024); } while (0)
#define PG8_LDB(dst, b, h) do { _Pragma("unroll") for (int n = 0; n < 2; ++n) _Pragma("unroll") for (int k = 0; k < 2; ++k) dst[n][k] = *(const PG8_LAS bf16x8*)(lds + PG8_SB(b, h) + boff + n * 2048 + k * 1024); } while (0)
#define PG8_MMA(ai, bj, At, Bt) do { __builtin_amdgcn_s_setprio(1); _Pragma("unroll") for (int m = 0; m < 4; ++m) _Pragma("unroll") for (int n = 0; n < 2; ++n) _Pragma("unroll") for (int k = 0; k < 2; ++k) \
        acc[ai][bj][m][n] = __builtin_amdgcn_mfma_f32_16x16x32_bf16(Bt[n][k], At[m][k], acc[ai][bj][m][n], 0, 0, 0); __builtin_amdgcn_s_setprio(0); } while (0)
#define PG8_WAIT_V(n) asm volatile("s_waitcnt vmcnt(" #n ")" ::: "memory")
#define PG8_WAIT_L(n) asm volatile("s_waitcnt lgkmcnt(" #n ")" ::: "memory")
#define PG8_BAR __builtin_amdgcn_s_barrier()
#define PG8_SCHED __builtin_amdgcn_sched_barrier(0)
    Unit cur, nxt; int ui = 0;
    if (!S.next(0, cur)) return;
    f32x4 acc[2][2][4][2];
#pragma unroll
    for (int a = 0; a < 2; ++a)
#pragma unroll
        for (int b = 0; b < 2; ++b)
#pragma unroll
            for (int m = 0; m < 4; ++m)
#pragma unroll
                for (int n = 0; n < 2; ++n) acc[a][b][m][n] = (f32x4){0.f, 0.f, 0.f, 0.f};
    bf16x8 At[4][2], B0[2][2], B1[2][2];
    const char* cA = (const char*)g.A + (size_t)cur.pm * tstep; const char* cB = (const char*)g.Bt + (size_t)cur.pn * tstep;
    S.a_ready(cur);
    if constexpr (SP2) {
        PG8_STAGE(PG8_SB(0, 0), cB, voffB); PG8_STAGE(PG8_SB(0, 1), cB + hstep, voffB); PG8_STAGE(PG8_SA(0, 0), cA, voffA); PG8_STAGE(PG8_SA(0, 1), cA + hstep, voffA);
        if (wr == 1) PG8_BAR;
        PG8_WAIT_V(2); PG8_BAR;
        PG8_STAGE(PG8_SB(1, 0), cB + kstep, voffB); PG8_STAGE(PG8_SA(1, 0), cA + kstep, voffA); PG8_STAGE(PG8_SB(1, 1), cB + hstep + kstep, voffB);
        PG8_WAIT_V(6); PG8_BAR;
    } else {
        PG8_STAGE(PG8_SB(0, 0), cB, voffB); PG8_STAGE(PG8_SA(0, 0), cA, voffA); PG8_STAGE(PG8_SB(0, 1), cB + hstep, voffB); PG8_STAGE(PG8_SA(0, 1), cA + hstep, voffA);
        if (wr == 1) PG8_BAR;
        PG8_WAIT_V(4); PG8_BAR;
        PG8_STAGE(PG8_SB(1, 0), cB + kstep, voffB); PG8_STAGE(PG8_SA(1, 0), cA + kstep, voffA); PG8_STAGE(PG8_SB(1, 1), cB + hstep + kstep, voffB);
        PG8_WAIT_V(6); PG8_BAR;
    }
    for (;;) {
        const bool has_next = S.next(ui + 1, nxt);
        const char* nA = has_next ? (const char*)g.A + (size_t)nxt.pm * tstep : cA; const char* nB = has_next ? (const char*)g.Bt + (size_t)nxt.pn * tstep : cB;
        for (int t = 0; t < nt; t += 2) {
            const bool last = (t == nt - 2);
            const char* a1 = cA + (size_t)(t + 1) * kstep;
            const char* a2 = last ? nA : cA + (size_t)(t + 2) * kstep; const char* b2 = last ? nB : cB + (size_t)(t + 2) * kstep;
            const char* a3 = a2 + kstep; const char* b3 = b2 + kstep;
            if (last && has_next) S.a_ready(nxt);
            if constexpr (SP2) {
            PG8_LDB(B0, 0, 0); PG8_LDB(B1, 0, 1); PG8_SCHED; PG8_LDA(At, 0, 0); PG8_STAGE(PG8_SA(1, 1), a1 + hstep, voffA);
            PG8_WAIT_V(8); PG8_WAIT_L(0); PG8_BAR; PG8_MMA(0, 0, At, B0); PG8_MMA(0, 1, At, B1); PG8_BAR; PG8_SCHED;
            PG8_LDA(At, 0, 1); PG8_STAGE(PG8_SB(0, 0), b2, voffB); PG8_STAGE(PG8_SB(0, 1), b2 + hstep, voffB); PG8_STAGE(PG8_SA(0, 0), a2, voffA);
            PG8_WAIT_V(8); PG8_WAIT_L(0); PG8_BAR; PG8_MMA(1, 0, At, B0); PG8_MMA(1, 1, At, B1); PG8_BAR; PG8_SCHED;
            PG8_LDB(B0, 1, 0); PG8_LDB(B1, 1, 1); PG8_SCHED; PG8_LDA(At, 1, 0); PG8_STAGE(PG8_SA(0, 1), a2 + hstep, voffA);
            PG8_WAIT_V(8); PG8_WAIT_L(0); PG8_BAR; PG8_MMA(0, 0, At, B0); PG8_MMA(0, 1, At, B1); PG8_BAR; PG8_SCHED;
            PG8_LDA(At, 1, 1); PG8_STAGE(PG8_SB(1, 0), b3, voffB); PG8_STAGE(PG8_SB(1, 1), b3 + hstep, voffB); PG8_STAGE(PG8_SA(1, 0), a3, voffA);
            PG8_WAIT_V(8); PG8_WAIT_L(0); PG8_BAR; PG8_MMA(1, 0, At, B0); PG8_MMA(1, 1, At, B1); PG8_BAR; PG8_SCHED;
            } else {
            PG8_LDB(B0, 0, 0); PG8_SCHED; PG8_LDA(At, 0, 0); PG8_STAGE(PG8_SA(1, 1), a1 + hstep, voffA);
            PG8_WAIT_L(8); PG8_BAR; PG8_WAIT_L(0); PG8_MMA(0, 0, At, B0); PG8_BAR; PG8_SCHED;
            PG8_LDB(B1, 0, 1); PG8_STAGE(PG8_SB(0, 0), b2, voffB);
            PG8_BAR; PG8_WAIT_L(0); PG8_MMA(0, 1, At, B1); PG8_BAR;
            PG8_LDA(At, 0, 1); PG8_STAGE(PG8_SA(0, 0), a2, voffA);
            PG8_BAR; PG8_WAIT_L(0); PG8_MMA(1, 0, At, B0); PG8_BAR; PG8_SCHED;
            PG8_STAGE(PG8_SB(0, 1), b2 + hstep, voffB);
            PG8_WAIT_V(6); PG8_BAR; PG8_MMA(1, 1, At, B1); PG8_BAR;
            PG8_LDB(B0, 1, 0); PG8_SCHED; PG8_LDA(At, 1, 0); PG8_STAGE(PG8_SA(0, 1), a2 + hstep, voffA);
            PG8_WAIT_L(8); PG8_BAR; PG8_WAIT_L(0); PG8_MMA(0, 0, At, B0); PG8_BAR; PG8_SCHED;
            PG8_LDB(B1, 1, 1); PG8_STAGE(PG8_SB(1, 0), b3, voffB);
            PG8_BAR; PG8_WAIT_L(0); PG8_MMA(0, 1, At, B1); PG8_BAR;
            PG8_LDA(At, 1, 1); PG8_STAGE(PG8_SA(1, 0), a3, voffA);
            PG8_BAR; PG8_WAIT_L(0); PG8_MMA(1, 0, At, B0); PG8_BAR; PG8_SCHED;
            PG8_STAGE(PG8_SB(1, 1), b3 + hstep, voffB);
            PG8_WAIT_V(6); PG8_BAR; PG8_MMA(1, 1, At, B1); PG8_BAR;
            }
        }
        if constexpr (ALIGN_EPI) { if (wr == 0) PG8_BAR; }
        if constexpr (!Epi::AFTER_DRAIN) { E(acc, cur, wr, wc, fr, fq);
#ifdef PROBE_EPI2
            if constexpr (Epi::IDEMPOTENT) E(acc, cur, wr, wc, fr, fq);
#endif
            S.done(cur); }
        if (!has_next) break;
#pragma unroll
        for (int a = 0; a < 2; ++a)
#pragma unroll
            for (int b = 0; b < 2; ++b)
#pragma unroll
                for (int m = 0; m < 4; ++m)
#pragma unroll
                    for (int n = 0; n < 2; ++n) acc[a][b][m][n] = (f32x4){0.f, 0.f, 0.f, 0.f};
        cur = nxt; cA = nA; cB = nB; ++ui;
        if constexpr (ALIGN_EPI) { if (wr == 1) PG8_BAR; }
    }
    PG8_WAIT_V(0);
    if constexpr (!ALIGN_EPI) { if (wr == 0) PG8_BAR; }
    PG8_BAR;
    if constexpr (Epi::AFTER_DRAIN) { E.fused(acc, cur, wr, wc, fr, fq, lds, wid, lane); S.done(cur); }
#undef PG8_SA
#undef PG8_SB
#undef PG8_STAGE
#undef PG8_LDA
#undef PG8_LDB
#undef PG8_MMA
#undef PG8_WAIT_V
#undef PG8_WAIT_L
#undef PG8_BAR
#undef PG8_SCHED
}
}

#define GAS __attribute__((address_space(1)))
#define LAS __attribute__((address_space(3)))
typedef unsigned short bf16_t;
typedef short bf16x8 __attribute__((ext_vector_type(8)));
typedef short s16x4 __attribute__((ext_vector_type(4)));
typedef float f32x2 __attribute__((ext_vector_type(2)));
typedef float f32x4 __attribute__((ext_vector_type(4)));
typedef float f32x16 __attribute__((ext_vector_type(16)));
typedef unsigned u32x2 __attribute__((ext_vector_type(2)));
typedef unsigned u32x4 __attribute__((ext_vector_type(4)));
typedef GAS unsigned gu32;
#define RLX_AGENT __ATOMIC_RELAXED, __HIP_MEMORY_SCOPE_AGENT
#define LDS_WAIT() asm volatile("s_waitcnt lgkmcnt(0)" ::: "memory")
#define VM_WAIT() asm volatile("s_waitcnt vmcnt(0)" ::: "memory")
#define SBAR() __builtin_amdgcn_sched_barrier(0)
__device__ __forceinline__ unsigned cvtpk(float lo, float hi) { unsigned r; asm volatile("v_cvt_pk_bf16_f32 %0, %1, %2" : "=v"(r) : "v"(lo), "v"(hi)); return r; }
__device__ __forceinline__ float bflo(unsigned w) { return __builtin_bit_cast(float, w << 16); }
__device__ __forceinline__ float bfhi(unsigned w) { return __builtin_bit_cast(float, w & 0xffff0000u); }
__device__ __forceinline__ int crow(int r, int hi) { return (r & 3) + 8 * (r >> 2) + 4 * hi; }
__device__ __forceinline__ float ex2f(float x) { return __builtin_amdgcn_exp2f(x); }
__device__ __forceinline__ float wave_sum(float v) {
#pragma unroll
    for (int o = 1; o < 64; o <<= 1) v += __shfl_xor(v, o);
    return v;
}
#define PK4(P, B_, OUT) do { unsigned a0_ = cvtpk(P[B_+0], P[B_+1]), a1_ = cvtpk(P[B_+2], P[B_+3]); unsigned b0_ = cvtpk(P[B_+4], P[B_+5]), b1_ = cvtpk(P[B_+6], P[B_+7]); \
        auto r0_ = __builtin_amdgcn_permlane32_swap(a0_, b0_, false, false); auto r1_ = __builtin_amdgcn_permlane32_swap(a1_, b1_, false, false); \
        u32x4 w_ = {r0_[0], r1_[0], r0_[1], r1_[1]}; OUT = __builtin_bit_cast(bf16x8, w_); } while (0)


namespace att {
constexpr int KTB = 64 * 384, VTB = 64 * 256;
constexpr int L_K0 = 0, L_K1 = KTB, L_V0 = 2 * KTB, L_V1 = 2 * KTB + VTB, L_WS = 2 * KTB + 2 * VTB, LDS_BYTES = L_WS + 8 * 64 * 4;
__device__ __forceinline__ int v_st(int k, int c) { const int kk = (k & ~0xC) | ((k & 4) << 1) | ((k & 8) >> 1); return ((kk >> 3) * 4 + (c >> 5)) * 512 + ((kk & 7) * 32 + (c & 31)) * 2; }
__device__ __forceinline__ int v_rd_base(int lane) { return ((lane & 3) << 3) | (((lane >> 2) & 3) << 6) | (((lane >> 4) & 1) << 5) | (((lane >> 5) & 1) << 8); }
constexpr int v_rd_off(int d0, int ks, int half) { return d0 * 512 + ks * 4096 + half * 2048; }

template <int KBUF>
__device__ __forceinline__ void qkt(f32x16& p0, f32x16& p1, LAS const unsigned char* lds, int r32, int hi, const bf16x8* qr) {
    p0 = f32x16{}; p1 = f32x16{};
    const int x = ((r32 >> 1) & 7) << 4;
    LAS const unsigned char* kb[4];
#pragma unroll
    for (int dd = 0; dd < 4; ++dd) kb[dd] = lds + KBUF * KTB + r32 * 384 + ((dd * 32 + hi * 16) ^ x);
#pragma unroll
    for (int d0 = 0; d0 < 12; ++d0) { LAS const unsigned char* a = kb[d0 & 3] + (d0 >> 2) * 128;
        const bf16x8 b0 = *(LAS const bf16x8*)a, b1 = *(LAS const bf16x8*)(a + 32 * 384);
        p0 = __builtin_amdgcn_mfma_f32_32x32x16_bf16(b0, qr[d0], p0, 0, 0, 0);
        p1 = __builtin_amdgcn_mfma_f32_32x32x16_bf16(b1, qr[d0], p1, 0, 0, 0); }
}
template <int VBUF>
__device__ __forceinline__ void pv_tile(f32x16* o, int vb0, bf16x8 pa0, bf16x8 pa1, bf16x8 pa2, bf16x8 pa3) {
#define TRRD(dst, off) asm volatile("ds_read_b64_tr_b16 %0, %1 offset:%2" : "=&v"(dst) : "v"(vb0), "i"(off) : "memory")
#define PV_D0(d0) do { s16x4 l0, l1, l2, l3, h0, h1, h2, h3; constexpr int b_ = VBUF * VTB + v_rd_off(d0, 0, 0); \
        TRRD(l0, b_); TRRD(h0, b_ + 2048); TRRD(l1, b_ + 4096); TRRD(h1, b_ + 6144); TRRD(l2, b_ + 8192); TRRD(h2, b_ + 10240); TRRD(l3, b_ + 12288); TRRD(h3, b_ + 14336); \
        asm volatile("s_waitcnt lgkmcnt(0)" ::: "memory"); SBAR(); \
        o[d0] = __builtin_amdgcn_mfma_f32_32x32x16_bf16(pa0, (bf16x8){l0[0], l0[1], l0[2], l0[3], h0[0], h0[1], h0[2], h0[3]}, o[d0], 0, 0, 0); \
        o[d0] = __builtin_amdgcn_mfma_f32_32x32x16_bf16(pa1, (bf16x8){l1[0], l1[1], l1[2], l1[3], h1[0], h1[1], h1[2], h1[3]}, o[d0], 0, 0, 0); \
        o[d0] = __builtin_amdgcn_mfma_f32_32x32x16_bf16(pa2, (bf16x8){l2[0], l2[1], l2[2], l2[3], h2[0], h2[1], h2[2], h2[3]}, o[d0], 0, 0, 0); \
        o[d0] = __builtin_amdgcn_mfma_f32_32x32x16_bf16(pa3, (bf16x8){l3[0], l3[1], l3[2], l3[3], h3[0], h3[1], h3[2], h3[3]}, o[d0], 0, 0, 0); } while (0)
    PV_D0(0); PV_D0(1); PV_D0(2); PV_D0(3);
#undef PV_D0
#undef TRRD
}

__device__ __forceinline__ void attn_unit(LAS unsigned char* lds, const bf16_t* __restrict__ QB, const bf16_t* __restrict__ KB, const bf16_t* __restrict__ VB,
                                          bf16_t* __restrict__ CAT, const float* __restrict__ onw, int b, int h, int qb) {
    int tid_ = threadIdx.x; asm volatile("" : "+v"(tid_));
    const int tid = tid_, wid = __builtin_amdgcn_readfirstlane(tid >> 6), lane = tid & 63, r32 = lane & 31, hi = lane >> 5;
    const int NT = 4 * (qb + 1);
    const int qlo = qb * 256 + wid * 32;
    const size_t tok0 = (size_t)b * SEQ;
    LAS float* wsf = (LAS float*)(lds + L_WS) + wid * 64; LAS float* li_l = wsf; LAS float* al_l = wsf + 32;
    bf16x8 qr[12];
    { const bf16_t* qp = QB + (tok0 + qlo + r32) * 1536 + h * 192 + hi * 8;
#pragma unroll
      for (int d0 = 0; d0 < 12; ++d0) qr[d0] = *(const bf16x8*)(qp + d0 * 16); }
    const int skey = tid >> 3, sch = tid & 7, kls = skey * 384 + ((sch * 16) ^ (((skey >> 1) & 7) << 4));
    const bf16_t* kg = KB + (tok0 + skey) * 1536 + h * 192 + sch * 8;
    const int sr = tid >> 4, sc = (tid & 15) * 8, vst0 = v_st(sr, sc), vst1 = v_st(32 + sr, sc);
    const bf16_t* vg = VB + (tok0 + sr) * 1024 + h * 128 + sc;
    bf16x8 stK0, stK1, stK2, stV0, stV1;
#define A_LOAD(t) do { const bf16_t* kp_ = kg + (size_t)(t) * (64 * 1536); stK0 = *(const bf16x8*)kp_; stK1 = *(const bf16x8*)(kp_ + 64); stK2 = *(const bf16x8*)(kp_ + 128); \
        const bf16_t* vp_ = vg + (size_t)(t) * (64 * 1024); stV0 = *(const bf16x8*)vp_; stV1 = *(const bf16x8*)(vp_ + 32 * 1024); } while (0)
#define A_WRITE(KOFF, VOFF) do { *(LAS bf16x8*)(lds + (KOFF) + kls) = stK0; *(LAS bf16x8*)(lds + (KOFF) + kls + 128) = stK1; *(LAS bf16x8*)(lds + (KOFF) + kls + 256) = stK2; \
        *(LAS bf16x8*)(lds + (VOFF) + vst0) = stV0; *(LAS bf16x8*)(lds + (VOFF) + vst1) = stV1; } while (0)
    float m_reg = -1e30f, l_reg = 0.f; f32x16 o[4] = {};
    const int vb0 = (int)(unsigned)(uintptr_t)(lds + L_V0) + v_rd_base(lane);
    A_LOAD(0); A_WRITE(L_K0, L_V0); __syncthreads();
#define A_STEP(t, BUFI, NKOFF, NVOFF) do { \
        if ((t) + 1 < NT) A_LOAD((t) + 1); \
        const int kb_ = (t) * 64; \
        if (kb_ <= qlo + 31) {                                     \
            f32x16 p0, p1; qkt<BUFI>(p0, p1, lds, r32, hi, qr); \
            if (kb_ + 63 > qlo) { const int dq = qlo + r32 - kb_; const float NEG = -__builtin_inff(); \
                _Pragma("unroll") for (int r = 0; r < 16; ++r) { const int c = crow(r, hi); if (c > dq) p0[r] = NEG; if (c + 32 > dq) p1[r] = NEG; } } \
            float pmax = fmaxf(p0[0], p1[0]); \
            _Pragma("unroll") for (int r = 1; r < 16; ++r) pmax = fmaxf(pmax, fmaxf(p0[r], p1[r])); \
            { auto rr = __builtin_amdgcn_permlane32_swap(__float_as_uint(pmax), __float_as_uint(pmax), false, false); pmax = fmaxf(__uint_as_float(rr[0]), __uint_as_float(rr[1])); } \
            const float mn = fmaxf(m_reg, pmax), alpha = ex2f(m_reg - mn); m_reg = mn; \
            float ps = 0.f; \
            _Pragma("unroll") for (int r = 0; r < 16; ++r) { p0[r] = ex2f(p0[r] - mn); p1[r] = ex2f(p1[r] - mn); ps += p0[r] + p1[r]; } \
            { auto rr = __builtin_amdgcn_permlane32_swap(__float_as_uint(ps), __float_as_uint(ps), false, false); ps = __uint_as_float(rr[0]) + __uint_as_float(rr[1]); } \
            l_reg = l_reg * alpha + ps; \
            bf16x8 pa0, pa1, pa2, pa3; PK4(p0, 0, pa0); PK4(p0, 8, pa1); PK4(p1, 0, pa2); PK4(p1, 8, pa3); \
            if (__any(alpha < 1.f)) { if (hi == 0) al_l[r32] = alpha; LDS_WAIT(); \
                _Pragma("unroll") for (int r = 0; r < 16; ++r) { const float a_ = al_l[crow(r, hi)]; _Pragma("unroll") for (int d_ = 0; d_ < 4; ++d_) o[d_][r] *= a_; } } \
            pv_tile<BUFI>(o, vb0, pa0, pa1, pa2, pa3); } \
        if ((t) + 1 < NT) A_WRITE(NKOFF, NVOFF); \
        __syncthreads(); } while (0)
    for (int t = 0; t < NT; t += 2) { A_STEP(t, 0, L_K1, L_V1); A_STEP(t + 1, 1, L_K0, L_V0); }
#undef A_STEP
#undef A_LOAD
#undef A_WRITE
    if (hi == 0) li_l[r32] = l_reg;
    LDS_WAIT();
    float sq[16];
#pragma unroll
    for (int r = 0; r < 16; ++r) { const float rl = __builtin_amdgcn_rcpf(li_l[crow(r, hi)]); float s = 0.f;
#pragma unroll
        for (int d = 0; d < 4; ++d) { const float v = o[d][r] * rl; o[d][r] = v; s += v * v; }
        sq[r] = s; }
#pragma unroll
    for (int off = 1; off < 32; off <<= 1)
#pragma unroll
        for (int r = 0; r < 16; ++r) sq[r] += __shfl_xor(sq[r], off);
    float w[4];
#pragma unroll
    for (int d = 0; d < 4; ++d) w[d] = onw[h * 128 + d * 32 + r32];
    bf16_t* op = CAT + (tok0 + qlo) * DM + h * 128 + r32;
#pragma unroll
    for (int r = 0; r < 16; ++r) { const float rn = __builtin_amdgcn_rsqf(sq[r] * (1.f / 128.f) + EPS); const int orow = crow(r, hi);
#pragma unroll
        for (int d = 0; d < 4; ++d) { const float v = o[d][r] * rn * w[d]; const float vn = __shfl_xor(v, 1);
            if ((r32 & 1) == 0) *(unsigned*)(op + (size_t)orow * DM + d * 32) = cvtpk(v, vn); } }
}
}


namespace scan {
constexpr int QI = 0, KI = 16384, KTT = 32768, VTT = 49152, STT = 65536, OT = 98304, OT_LD = 132, TOT = OT + 64 * OT_LD * 4  , FA = TOT + 8 * 128 * 4  , FB = FA + 512, FR = FB + 512, LDS_BYTES = FR + 512;
__device__ __forceinline__ int sw256(int row, int colB) { return row * 256 + (colB ^ ((row & 15) << 4)); }
__device__ __forceinline__ int sw128(int row, int colB) { return row * 128 + (colB ^ (((row >> 1) & 7) << 4)); }

__device__ __forceinline__ void scan_item(LAS unsigned char* lds, int type, int b, int h, const bf16_t* __restrict__ Qg, const bf16_t* __restrict__ Kg, const bf16_t* __restrict__ Vg,
                                          const bf16_t* __restrict__ Gt, const float* __restrict__ LF, const float* __restrict__ nw, bf16_t* __restrict__ CAT, int cbase) {
    int tid_ = threadIdx.x; asm volatile("" : "+v"(tid_));
    const int tid = tid_, wid = __builtin_amdgcn_readfirstlane(tid >> 6), lane = tid & 63, r32 = lane & 31, hi = lane >> 5;
    const int ib = wid >> 2, eb = wid & 3, cg = lane, rg = wid;
    const float lg = log1pf(-exp2f(-5.f - (float)h));
    LAS float* tot = (LAS float*)(lds + TOT); LAS float* fa = (LAS float*)(lds + FA); LAS float* fb = (LAS float*)(lds + FB); LAS float* fr = (LAS float*)(lds + FR);
    LAS float* ot = (LAS float*)(lds + OT);
    f32x16 S0 = {}, S1 = {};
    const size_t tok0 = (size_t)b * SEQ;
    unsigned q[8], k[8], v[8]; f32x2 lf[8];
#define S_LOAD(c) do { _Pragma("unroll") for (int r = 0; r < 8; ++r) { const size_t off_ = (tok0 + (c) * 64 + 8 * rg + r) * 512 + h * 128 + 2 * cg; \
        q[r] = *(const unsigned*)(Qg + off_); k[r] = *(const unsigned*)(Kg + off_); v[r] = *(const unsigned*)(Vg + off_); \
        { const f32x2 l2_ = *(const f32x2*)(LF + off_); lf[r] = type ? l2_ : (f32x2){lg, lg}; } } } while (0)
    S_LOAD(0);
    for (int c = 0; c < SEQ / 64; ++c) {
        float c0[8], c1[8];
        { float a0 = 0.f, a1 = 0.f;
#pragma unroll
          for (int r = 0; r < 8; ++r) { a0 += lf[r].x; a1 += lf[r].y; c0[r] = a0; c1[r] = a1; } }
        *(LAS f32x2*)(tot + rg * 128 + 2 * cg) = (f32x2){c0[7], c1[7]};
        __syncthreads();
        float off0 = 0.f, off1 = 0.f, mid0 = 0.f, mid1 = 0.f, last0 = 0.f, last1 = 0.f;
#pragma unroll
        for (int g = 0; g < 8; ++g) { const f32x2 t2 = *(LAS const f32x2*)(tot + g * 128 + 2 * cg);
            if (g < rg) { off0 += t2.x; off1 += t2.y; } if (g < 4) { mid0 += t2.x; mid1 += t2.y; } last0 += t2.x; last1 += t2.y; }
        float kt0[8], kt1[8];
#pragma unroll
        for (int r = 0; r < 8; ++r) { const float b0 = off0 + c0[r], b1 = off1 + c1[r];
            const float qa = ex2f((b0 - mid0) * LOG2E), qb2 = ex2f((b1 - mid1) * LOG2E), ka = ex2f((mid0 - b0) * LOG2E), kb2 = ex2f((mid1 - b1) * LOG2E);
            const int row = 8 * rg + r;
            *(LAS unsigned*)(lds + QI + sw256(row, 4 * cg)) = cvtpk(bflo(q[r]) * qa, bfhi(q[r]) * qb2);
            kt0[r] = bflo(k[r]) * ka; kt1[r] = bfhi(k[r]) * kb2;
            *(LAS unsigned*)(lds + KI + sw256(row, 4 * cg)) = cvtpk(kt0[r], kt1[r]); }
        { u32x4 w0, w1, x0, x1;
          w0.x = cvtpk(kt0[0], kt0[1]); w0.y = cvtpk(kt0[2], kt0[3]); w0.z = cvtpk(kt0[4], kt0[5]); w0.w = cvtpk(kt0[6], kt0[7]);
          w1.x = cvtpk(kt1[0], kt1[1]); w1.y = cvtpk(kt1[2], kt1[3]); w1.z = cvtpk(kt1[4], kt1[5]); w1.w = cvtpk(kt1[6], kt1[7]);
          x0.x = (v[0] & 0xffffu) | (v[1] << 16); x0.y = (v[2] & 0xffffu) | (v[3] << 16); x0.z = (v[4] & 0xffffu) | (v[5] << 16); x0.w = (v[6] & 0xffffu) | (v[7] << 16);
          x1.x = (v[0] >> 16) | (v[1] & 0xffff0000u); x1.y = (v[2] >> 16) | (v[3] & 0xffff0000u); x1.z = (v[4] >> 16) | (v[5] & 0xffff0000u); x1.w = (v[6] >> 16) | (v[7] & 0xffff0000u);
          *(LAS u32x4*)(lds + KTT + sw128(2 * cg, 16 * rg)) = w0; *(LAS u32x4*)(lds + KTT + sw128(2 * cg + 1, 16 * rg)) = w1;
          *(LAS u32x4*)(lds + VTT + sw128(2 * cg, 16 * rg)) = x0; *(LAS u32x4*)(lds + VTT + sw128(2 * cg + 1, 16 * rg)) = x1; }
        if (rg == 0) { *(LAS f32x2*)(fa + 2 * cg) = (f32x2){ex2f(last0 * LOG2E), ex2f(last1 * LOG2E)};
                       *(LAS f32x2*)(fb + 2 * cg) = (f32x2){ex2f((last0 - mid0) * LOG2E), ex2f((last1 - mid1) * LOG2E)};
                       *(LAS f32x2*)(fr + 2 * cg) = (f32x2){ex2f(mid0 * LOG2E), ex2f(mid1 * LOG2E)}; }
        if (c + 1 < SEQ / 64) S_LOAD(c + 1);
        __syncthreads();
        { const int e = 32 * eb + r32;
#pragma unroll
          for (int blk = 0; blk < 2; ++blk) { const f32x16& Sb = blk ? S1 : S0; const int db = 2 * ib + blk;
#pragma unroll
            for (int g = 0; g < 4; ++g) { const int d0 = 32 * db + 8 * g + 4 * hi; const f32x4 f = *(LAS const f32x4*)(fr + d0);
                u32x2 w; w.x = cvtpk(Sb[4 * g] * f[0], Sb[4 * g + 1] * f[1]); w.y = cvtpk(Sb[4 * g + 2] * f[2], Sb[4 * g + 3] * f[3]);
                *(LAS u32x2*)(lds + STT + sw256(e, 2 * d0)) = w; } } }
        __syncthreads();
        { const int i = 32 * ib + r32, e = 32 * eb + r32;
          bf16x8 qf[8];
#pragma unroll
          for (int s = 0; s < 8; ++s) qf[s] = *(LAS const bf16x8*)(lds + QI + sw256(i, 32 * s + 16 * hi));
          f32x16 O = {};
#pragma unroll
          for (int s = 0; s < 8; ++s) { const bf16x8 sf = *(LAS const bf16x8*)(lds + STT + sw256(e, 32 * s + 16 * hi)); O = __builtin_amdgcn_mfma_f32_32x32x16_bf16(qf[s], sf, O, 0, 0, 0); }
#pragma unroll
          for (int jb = 0; jb < 2; ++jb) if (jb <= ib) {
              f32x16 pT = {}; const int j = 32 * jb + r32;
#pragma unroll
              for (int s = 0; s < 8; ++s) { const bf16x8 kf = *(LAS const bf16x8*)(lds + KI + sw256(j, 32 * s + 16 * hi)); pT = __builtin_amdgcn_mfma_f32_32x32x16_bf16(kf, qf[s], pT, 0, 0, 0); }
              if (jb == ib) {
#pragma unroll
                  for (int r = 0; r < 16; ++r) if (crow(r, hi) > r32) pT[r] = 0.f; }
              bf16x8 pa0, pa1; PK4(pT, 0, pa0); PK4(pT, 8, pa1);
              const bf16x8 vf0 = *(LAS const bf16x8*)(lds + VTT + sw128(e, 64 * jb + 16 * hi)), vf1 = *(LAS const bf16x8*)(lds + VTT + sw128(e, 64 * jb + 32 + 16 * hi));
              O = __builtin_amdgcn_mfma_f32_32x32x16_bf16(pa0, vf0, O, 0, 0, 0); O = __builtin_amdgcn_mfma_f32_32x32x16_bf16(pa1, vf1, O, 0, 0, 0); }
#pragma unroll
          for (int r = 0; r < 16; ++r) ot[(32 * ib + crow(r, hi)) * OT_LD + e] = O[r];
#pragma unroll
          for (int blk = 0; blk < 2; ++blk) { const int db = 2 * ib + blk, d = 32 * db + r32; f32x16 T = {};
#pragma unroll
            for (int s = 0; s < 4; ++s) { const bf16x8 kf = *(LAS const bf16x8*)(lds + KTT + sw128(d, 32 * s + 16 * hi)), vf = *(LAS const bf16x8*)(lds + VTT + sw128(e, 32 * s + 16 * hi));
                T = __builtin_amdgcn_mfma_f32_32x32x16_bf16(kf, vf, T, 0, 0, 0); }
#pragma unroll
            for (int g = 0; g < 4; ++g) { const int d0 = 32 * db + 8 * g + 4 * hi; const f32x4 a4 = *(LAS const f32x4*)(fa + d0), b4 = *(LAS const f32x4*)(fb + d0);
#pragma unroll
                for (int jj = 0; jj < 4; ++jj) { if (blk) S1[4 * g + jj] = S1[4 * g + jj] * a4[jj] + T[4 * g + jj] * b4[jj]; else S0[4 * g + jj] = S0[4 * g + jj] * a4[jj] + T[4 * g + jj] * b4[jj]; } } } }
        __syncthreads();
        { const int row = tid >> 3, seg = tid & 7; const LAS float* op = ot + row * OT_LD + 16 * seg;
          float x[16];
#pragma unroll
          for (int i4 = 0; i4 < 4; ++i4) { const f32x4 t4 = *(LAS const f32x4*)(op + 4 * i4); x[4 * i4] = t4[0]; x[4 * i4 + 1] = t4[1]; x[4 * i4 + 2] = t4[2]; x[4 * i4 + 3] = t4[3]; }
          float s1 = 0.f;
#pragma unroll
          for (int i = 0; i < 16; ++i) s1 += x[i];
          s1 += __shfl_xor(s1, 1); s1 += __shfl_xor(s1, 2); s1 += __shfl_xor(s1, 4);
          const float mu = type ? 0.f : s1 * (1.f / 128.f);
          float s2 = 0.f;
#pragma unroll
          for (int i = 0; i < 16; ++i) { x[i] -= mu; s2 += x[i] * x[i]; }
          s2 += __shfl_xor(s2, 1); s2 += __shfl_xor(s2, 2); s2 += __shfl_xor(s2, 4);
          const float rn = __builtin_amdgcn_rsqf(s2 * (1.f / 128.f) + EPS);
          const size_t grow = tok0 + c * 64 + row;
          const u32x4 g0 = *(const u32x4*)(Gt + grow * 512 + h * 128 + 16 * seg), g1 = *(const u32x4*)(Gt + grow * 512 + h * 128 + 16 * seg + 8);
          const unsigned gw[8] = {g0.x, g0.y, g0.z, g0.w, g1.x, g1.y, g1.z, g1.w};
          const float* wp = nw + h * 128 + 16 * seg;
          unsigned ow[8];
#pragma unroll
          for (int p = 0; p < 8; ++p) ow[p] = cvtpk(x[2 * p] * rn * wp[2 * p] * bflo(gw[p]), x[2 * p + 1] * rn * wp[2 * p + 1] * bfhi(gw[p]));
          bf16_t* cp = CAT + grow * DM + cbase + h * 128 + 16 * seg;
          *(u32x4*)cp = (u32x4){ow[0], ow[1], ow[2], ow[3]}; *(u32x4*)(cp + 8) = (u32x4){ow[4], ow[5], ow[6], ow[7]}; }
    }
#undef S_LOAD
    __syncthreads();
}
}


constexpr size_t MiB = 1u << 20;
constexpr size_t WS_CTL = 0, CTL_ZERO_BYTES = 4 * MiB;
constexpr int CW_TMO = 0, CW_BAR = 4096, CW_QHEAD = 8192;
constexpr size_t WS_SS = 1 * MiB;
constexpr size_t WS_TAB = 4 * MiB;
constexpr size_t TAB_CM = 0, TAB_SM = 262144, TAB_CR = 524288, TAB_SR = 1048576, TAB_LB = 1572864;
constexpr size_t WS_W = 8 * MiB, W_LAYER = 167 * MiB;
constexpr size_t W_UP1 = 0, W_DN1 = 44 * MiB, W_IN = 66 * MiB, W_KVB = 91 * MiB, W_O = 93 * MiB, W_UP2 = 101 * MiB, W_DN2 = 145 * MiB;
constexpr size_t WS_HB = WS_W + 4 * W_LAYER;
constexpr size_t WS_ACT = WS_HB + 64 * MiB;
constexpr size_t A_QB = 0, A_KB = 48 * MiB, A_VB = 96 * MiB, A_CKV = 128 * MiB, A_RQ = 144 * MiB, A_RK = 160 * MiB, A_RV = 176 * MiB, A_RG = 192 * MiB,
                 A_HQ = 208 * MiB, A_HK = 224 * MiB, A_HV = 240 * MiB, A_HG = 256 * MiB, A_HLF = 272 * MiB, A_CAT = 304 * MiB, A_END = 368 * MiB;
constexpr size_t WS_END = WS_ACT + A_END;
static_assert(A_RK - A_RQ == (size_t)M * 512 * 2 && A_HG - A_RQ == 7 * (A_RK - A_RQ) && TAB_SM == 65536 * 4 && TAB_CR == 131072 * 4 && TAB_SR == 262144 * 4, "EpiIn indexes these by stride");
static_assert((size_t)NUP * DM * 2 == 44 * MiB && (size_t)DM * DFF * 2 == 22 * MiB && (size_t)NIN * DM * 2 == 25 * MiB && (size_t)M * DFF * 2 <= A_END, "d_ws map");

constexpr int LDS_BYTES = 147456;
constexpr int MISC_OFF = LDS_BYTES - 256;
static_assert(scan::LDS_BYTES <= MISC_OFF && att::LDS_BYTES <= MISC_OFF && pg8::STAGE_BYTES <= MISC_OFF, "LDS map");

__device__ __forceinline__ int map_in(int s) {
    if (s < 1536) { const int head = s / 192, d = s - head * 192; if (d < 128) return head * 128 + d; const int rd = d - 128; return 1024 + head * 64 + (rd < 32 ? 2 * rd : 2 * (rd - 32) + 1); }
    if (s < 2048) return s;
    if (s < 2112) { const int rd = s - 2048; return 2048 + (rd < 32 ? 2 * rd : 2 * (rd - 32) + 1); }
    if (s < 3136) { const int e = s - 2112, hh = e >> 7, rd = e & 127; return 2304 + hh * 128 + (rd < 64 ? 2 * rd : 2 * (rd - 64) + 1); }
    return s + 192;
}
__device__ __forceinline__ void tr_item(const float* __restrict__ W, int K, int N, const float* __restrict__ g, bf16_t* __restrict__ WT, int kind, int item, LAS float* scr, int lane) {
    const int nblk = N >> 6, kb = item / nblk, nb = item - kb * nblk, k0 = 64 * kb, n0 = 64 * nb;
    { const int kr = lane >> 4, c4 = 4 * (lane & 15); const float* src = W + (size_t)(k0 + kr) * N + n0 + c4;
#pragma unroll 4
      for (int i = 0; i < 16; ++i) { const f32x4 v = *(const f32x4*)(src + (size_t)(4 * i) * N); LAS float* d = scr + (4 * i + kr) * 65 + c4; d[0] = v[0]; d[1] = v[1]; d[2] = v[2]; d[3] = v[3]; } }
    LDS_WAIT(); asm volatile("" ::: "memory");
    const int nn = lane & 7, c = lane >> 3;
    float gk[8];
    if (g) { const f32x4 g0 = *(const f32x4*)(g + k0 + 8 * c), g1 = *(const f32x4*)(g + k0 + 8 * c + 4); gk[0] = g0[0]; gk[1] = g0[1]; gk[2] = g0[2]; gk[3] = g0[3]; gk[4] = g1[0]; gk[5] = g1[1]; gk[6] = g1[2]; gk[7] = g1[3]; }
    else {
#pragma unroll
        for (int i = 0; i < 8; ++i) gk[i] = 1.f; }
#pragma unroll
    for (int j = 0; j < 8; ++j) { const int n = nn + 8 * j, ns = n0 + n; const LAS float* s = scr + (8 * c) * 65 + n;
        int dr = ns; if (kind == 1) dr = 256 * (ns >> 7) + (ns & 127); else if (kind == 2) dr = 256 * (ns >> 7) + (ns & 127) + 128; else if (kind == 3) dr = map_in(ns);
        u32x4 o; o.x = cvtpk(s[0] * gk[0], s[65] * gk[1]); o.y = cvtpk(s[2 * 65] * gk[2], s[3 * 65] * gk[3]); o.z = cvtpk(s[4 * 65] * gk[4], s[5 * 65] * gk[5]); o.w = cvtpk(s[6 * 65] * gk[6], s[7 * 65] * gk[7]);
        *(u32x4*)(WT + (size_t)dr * K + k0 + 8 * c) = o; }
    LDS_WAIT(); asm volatile("" ::: "memory");
}

#define XB_TMO      128
#define XB_XCNT(j)  (256  + 64 * (j))
#define XB_XSUB(j)  (1280 + 64 * (j))
#define XB_XGEN(j)  (2304 + 64 * (j))
#define XB_TOP      3328
#define XB_TOPGEN   3392
#define XCD_BAR_WORDS 3456
#define XB_SPIN_CAP (1u << 18)

__device__ __forceinline__ unsigned xb_ld(unsigned* p)              { return __hip_atomic_load(p, __ATOMIC_RELAXED, __HIP_MEMORY_SCOPE_AGENT); }
__device__ __forceinline__ unsigned xb_add(unsigned* p, unsigned v) { return __hip_atomic_fetch_add(p, v, __ATOMIC_RELAXED, __HIP_MEMORY_SCOPE_AGENT); }
__device__ __forceinline__ unsigned xb_xcc_id() { return (unsigned)__builtin_amdgcn_s_getreg((3 << 11) | 20) & 0xFu; }
#define XB_SPIN(cond, bar) do { unsigned _sp = 0; while (cond) { __builtin_amdgcn_s_sleep(1); \
    if ((++_sp & 255u) == 0u) { if (xb_ld(&(bar)[XB_TMO])) break; if (_sp > XB_SPIN_CAP) { atomicAdd(&(bar)[XB_TMO], 1u); break; } } } } while (0)

struct XcdBarrier {
    unsigned* bar; unsigned x;
    volatile LAS unsigned* st;
};

__device__ __forceinline__ XcdBarrier xcd_barrier_post(unsigned* bar, volatile LAS unsigned* st) {
    XcdBarrier b; b.bar = bar; b.x = xb_xcc_id(); b.st = st;
    if (threadIdx.x == 0) (void)xb_add(&bar[XB_XCNT(b.x)], 1u);
    return b;
}
__device__ __forceinline__ void xcd_barrier_complete(unsigned* bar, unsigned x, unsigned& nloc, unsigned& nx) {
    const unsigned G = gridDim.x * gridDim.y * gridDim.z;
    unsigned sum, cnt, mine, sp = 0u;
    for (;;) {
        sum = 0u; cnt = 0u; mine = 0u;
#pragma unroll
        for (unsigned j = 0; j < 16; ++j) { const unsigned c = xb_ld(&bar[XB_XCNT(j)]); sum += c; cnt += (c > 0u) ? 1u : 0u; mine = (j == x) ? c : mine; }
        if (sum == G) break;
        __builtin_amdgcn_s_sleep(1);
        if ((++sp & 255u) == 0u) { if (xb_ld(&bar[XB_TMO])) break; if (sp > XB_SPIN_CAP) { atomicAdd(&bar[XB_TMO], 1u); break; } }
    }
    nloc = mine > 0u ? mine : 1u; nx = cnt > 0u ? cnt : 1u;
}

__device__ __forceinline__ void xcd_barrier(const XcdBarrier& b) {
    asm volatile("s_waitcnt vmcnt(0)" ::: "memory");
    __syncthreads();
    if (threadIdx.x == 0) {
        unsigned* bar = b.bar;
        __builtin_amdgcn_s_waitcnt(0);
        unsigned nloc = b.st[0], nx = b.st[1];
        if (nloc == 0u) { xcd_barrier_complete(bar, b.x, nloc, nx); b.st[0] = nloc; b.st[1] = nx; }
        const unsigned old = xb_add(&bar[XB_XSUB(b.x)], 1u);
        const unsigned gen = old / nloc;
        if (old + 1u == (gen + 1u) * nloc) {
            __builtin_amdgcn_fence(__ATOMIC_RELEASE, "agent");
            asm volatile("s_waitcnt vmcnt(0)" ::: "memory");
            const unsigned og = xb_add(&bar[XB_TOP], 1u);
            const unsigned tg = og / nx;
            if (og + 1u == (tg + 1u) * nx) xb_add(&bar[XB_TOPGEN], 1u);
            else XB_SPIN(xb_ld(&bar[XB_TOPGEN]) == tg, bar);
            __builtin_amdgcn_fence(__ATOMIC_ACQUIRE, "agent");
            xb_add(&bar[XB_XGEN(b.x)], 1u);
            asm volatile("s_waitcnt vmcnt(0)" ::: "memory");
        } else {
            XB_SPIN(xb_ld(&bar[XB_XGEN(b.x)]) == gen, bar);
            __builtin_amdgcn_fence(__ATOMIC_ACQUIRE, "agent");
            asm volatile("s_waitcnt vmcnt(0)" ::: "memory");
        }
    }
    __syncthreads();
}

__device__ __forceinline__ void sincos_d(float ang, float& s, float& c) {
    const double x = (double)ang, k = __builtin_rint(x * 0.6366197723675814), r = __builtin_fma(-k, 1.5707963267948966, x) - k * 6.123233995736766e-17, r2 = r * r;
    double sp = -1.0 / 6227020800.0; sp = sp * r2 + 1.0 / 39916800.0; sp = sp * r2 - 1.0 / 362880.0; sp = sp * r2 + 1.0 / 5040.0; sp = sp * r2 - 1.0 / 120.0; sp = sp * r2 + 1.0 / 6.0;
    const double sr = r - r * r2 * sp;
    double cp = 1.0 / 479001600.0; cp = cp * r2 - 1.0 / 3628800.0; cp = cp * r2 + 1.0 / 40320.0; cp = cp * r2 - 1.0 / 720.0; cp = cp * r2 + 1.0 / 24.0; cp = cp * r2 - 0.5;
    const double cr = 1.0 + r2 * cp;
    const int q = (int)k & 3;
    const double ss_ = (q == 0) ? sr : (q == 1) ? cr : (q == 2) ? -sr : -cr, cc_ = (q == 0) ? cr : (q == 1) ? -sr : (q == 2) ? -cr : sr;
    s = (float)ss_; c = (float)cc_;
}

#ifndef ALPHA_MASK
#define ALPHA_MASK 0xFFF
#endif
#ifndef REP_P0
#define REP_P0 1
#endif
#ifndef REP_UP
#define REP_UP 1
#endif
#ifndef REP_IN
#define REP_IN 1
#endif
#ifndef REP_KVB
#define REP_KVB 1
#endif
#ifndef REP_DN
#define REP_DN 1
#endif
#ifndef REP_OP
#define REP_OP 1
#endif
#ifndef REP_MIX
#define REP_MIX 1
#endif
constexpr int NPH = 50;
struct Args { const float* in[19]; float* out; unsigned char* ws; int ph_lo, ph_hi; };
__global__ void __launch_bounds__(512, 2) mk_fwd(Args args) {
    extern __shared__ __attribute__((aligned(16))) unsigned char lds_raw[];
    LAS unsigned char* lds = (LAS unsigned char*)lds_raw;
    volatile LAS unsigned* MISC = (volatile LAS unsigned*)(lds + MISC_OFF);
    const int tid0 = threadIdx.x, G = gridDim.x;
#define LAUNDER_TID() int tid = tid0; asm volatile("" : "+v"(tid)); const int lane = tid & 63, wave = __builtin_amdgcn_readfirstlane(tid >> 6); const int gw = blockIdx.x * 8 + wave, NGW = G * 8; (void)lane; (void)gw; (void)NGW
    if (tid0 < 64) MISC[tid0] = 0u;
    __syncthreads();
    unsigned char* ws = args.ws;
    gu32* ctl = (gu32*)(ws + WS_CTL);
    XcdBarrier bar; bar.bar = (unsigned*)(ws + WS_CTL) + CW_BAR; bar.x = 0; bar.st = nullptr;
    if (MK_ONE_LAUNCH) bar = xcd_barrier_post((unsigned*)(ws + WS_CTL) + CW_BAR, MISC + 8);
#define GRID_BAR() do { if (MK_ONE_LAUNCH) xcd_barrier(bar); } while (0)
    const int lo = args.ph_lo, hi = args.ph_hi;
#define IN(k) (lo <= (k) && (k) < hi)
    const float* x = args.in[0]; float* out = args.out;
    pg8::ss_t* ss = (pg8::ss_t*)(ws + WS_SS);
    const float* cM = (const float*)(ws + WS_TAB + TAB_CM); const float* sM = (const float*)(ws + WS_TAB + TAB_SM);
    const float* cR = (const float*)(ws + WS_TAB + TAB_CR); const float* sR = (const float*)(ws + WS_TAB + TAB_SR); const float* lbt = (const float*)(ws + WS_TAB + TAB_LB);
    bf16_t* HB = (bf16_t*)(ws + WS_HB);
    unsigned char* act = ws + WS_ACT;
    bf16_t* Gb = (bf16_t*)act;
    bf16_t *QB = (bf16_t*)(act + A_QB), *KB = (bf16_t*)(act + A_KB), *VB = (bf16_t*)(act + A_VB), *CKV = (bf16_t*)(act + A_CKV), *RQ = (bf16_t*)(act + A_RQ), *RK = (bf16_t*)(act + A_RK),
           *RV = (bf16_t*)(act + A_RV), *RG = (bf16_t*)(act + A_RG), *HQ = (bf16_t*)(act + A_HQ), *HK = (bf16_t*)(act + A_HK), *HV = (bf16_t*)(act + A_HV), *HG = (bf16_t*)(act + A_HG),
           *CAT = (bf16_t*)(act + A_CAT);
    float* HLF = (float*)(act + A_HLF);

#ifndef NO_P0
    if (IN(0)) for (int rep_ = 0; rep_ < REP_P0; ++rep_) { asm volatile("; MARK_P0"); LAUNDER_TID();
        LAS float* scr = (LAS float*)(lds + wave * 16640);
        constexpr int I_UP = 32 * 88, I_DN = 88 * 32, I_IN = 32 * 97, I_KVB = 8 * 32, I_O = 32 * 32, I_LAYER = 6 * I_UP + I_IN + I_KVB + I_O;
        static_assert(I_UP == I_DN, "item counts");
        for (int it = gw; it < 4 * I_LAYER; it += NGW) {
            const int l = it / I_LAYER; int r = it - l * I_LAYER;
            unsigned char* wl = ws + WS_W + (size_t)l * W_LAYER;
            const float* W; const float* g; bf16_t* WT; int K, N, kind;
            if (r < 3 * I_UP) { const int w = r / I_UP; r -= w * I_UP;
                if (w == 0) { W = args.in[2] + (size_t)l * DM * DFF; g = args.in[1] + l * DM; WT = (bf16_t*)(wl + W_UP1); K = DM; N = DFF; kind = 1; }
                else if (w == 1) { W = args.in[3] + (size_t)l * DM * DFF; g = args.in[1] + l * DM; WT = (bf16_t*)(wl + W_UP1); K = DM; N = DFF; kind = 2; }
                else { W = args.in[4] + (size_t)l * DFF * DM; g = nullptr; WT = (bf16_t*)(wl + W_DN1); K = DFF; N = DM; kind = 0; } }
            else if ((r -= 3 * I_UP) < I_IN) { W = args.in[6] + (size_t)l * DM * DIN; g = args.in[5] + l * DM; WT = (bf16_t*)(wl + W_IN); K = DM; N = DIN; kind = 3; }
            else if ((r -= I_IN) < I_KVB) { W = args.in[8] + (size_t)l * KVR * 2048; g = args.in[7] + l * KVR; WT = (bf16_t*)(wl + W_KVB); K = KVR; N = 2048; kind = 0; }
            else if ((r -= I_KVB) < I_O) { W = args.in[13] + (size_t)l * DM * DM; g = nullptr; WT = (bf16_t*)(wl + W_O); K = DM; N = DM; kind = 0; }
            else { r -= I_O; const int w = r / I_UP; r -= w * I_UP;
                if (w == 0) { W = args.in[15] + (size_t)l * DM * DFF; g = args.in[14] + l * DM; WT = (bf16_t*)(wl + W_UP2); K = DM; N = DFF; kind = 1; }
                else if (w == 1) { W = args.in[16] + (size_t)l * DM * DFF; g = args.in[14] + l * DM; WT = (bf16_t*)(wl + W_UP2); K = DM; N = DFF; kind = 2; }
                else { W = args.in[17] + (size_t)l * DFF * DM; g = nullptr; WT = (bf16_t*)(wl + W_DN2); K = DFF; N = DM; kind = 0; } }
            tr_item(W, K, N, g, WT, kind, r, scr, lane);
        }
        { const int gt = blockIdx.x * 512 + tid, NT_ = G * 512;
          for (int i = gt; i < 4 * 49152; i += NT_) { const int l = i / 49152, r = i - l * 49152;
              *(u32x4*)(ws + WS_W + (size_t)l * W_LAYER + W_IN + (size_t)2112 * DM * 2 + (size_t)r * 16) = (u32x4){0u, 0u, 0u, 0u}; }
          float* cMw = (float*)(ws + WS_TAB + TAB_CM); float* sMw = (float*)(ws + WS_TAB + TAB_SM); float* cRw = (float*)(ws + WS_TAB + TAB_CR); float* sRw = (float*)(ws + WS_TAB + TAB_SR);
          for (int i = gt; i < SEQ * 32; i += NT_) { const int t = i >> 5, f = i & 31; double iv = 1.0; for (int k = 0; k < f; ++k) iv *= 0.7498942093324559;
              float s_, c_; sincos_d((float)t * (float)iv, s_, c_); cMw[i] = c_; sMw[i] = s_; }
          for (int i = gt; i < SEQ * 64; i += NT_) { const int t = i >> 6, f = i & 63; double iv = 1.0; for (int k = 0; k < f; ++k) iv *= 0.8659643233600653;
              float s_, c_; sincos_d((float)t * (float)iv, s_, c_); cRw[i] = c_; sRw[i] = s_; }
          float* lbw = (float*)(ws + WS_TAB + TAB_LB); const float* lg = args.in[11];
          for (int i = gt; i < 512; i += NT_) { const float x0 = lg[i], x1 = lg[512 + i], x2 = lg[1024 + i], x3 = lg[1536 + i], mx = fmaxf(fmaxf(x0, x1), fmaxf(x2, x3));
              const float e0 = __expf(x0 - mx), e1 = __expf(x1 - mx), e2 = __expf(x2 - mx), e3 = __expf(x3 - mx), inv = 1.f / (e0 + e1 + e2 + e3);
              lbw[i] = 0.f; lbw[512 + i] = e1 * inv; lbw[1024 + i] = (e1 + e2) * inv; lbw[1536 + i] = (e1 + e2 + e3) * inv; } }
        for (int m = gw; m < M; m += NGW) {
            const f32x4* xr = (const f32x4*)(x + (size_t)m * DM) + lane; f32x4 v[8]; float s = 0.f;
#pragma unroll
            for (int j = 0; j < 8; ++j) { v[j] = xr[64 * j]; s += (v[j][0] * v[j][0] + v[j][1] * v[j][1]) + (v[j][2] * v[j][2] + v[j][3] * v[j][3]); }
            s = wave_sum(s); if (lane == 0) ss[m] = (pg8::ss_t)(s * 1048576.f + 0.5f);
            u32x2* o8 = (u32x2*)(HB + (size_t)m * DM) + lane;
#pragma unroll
            for (int j = 0; j < 8; ++j) o8[64 * j] = (u32x2){cvtpk(v[j][0], v[j][1]), cvtpk(v[j][2], v[j][3])};
        }
        GRID_BAR();
    }
#endif

    for (int hl = 0; hl < 8; ++hl) {
        const int l = hl >> 1, second = hl & 1, pb = 1 + 6 * hl;
        unsigned char* wl = ws + WS_W + (size_t)l * W_LAYER;
        const pg8::ss_t* ss_in = ss + (size_t)(3 * l + (second ? 2 : 0)) * M;
        pg8::ss_t* ss_out = ss + (size_t)(3 * l + (second ? 3 : 1)) * M;
#ifndef NO_UP
        if (IN(pb)) for (int rep_ = 0; rep_ < REP_UP; ++rep_) { asm volatile("; MARK_UP");
            pg8::Gemm g{HB, (const bf16_t*)(wl + (second ? W_UP2 : W_UP1)), M, NUP, DM}; pg8::StaticOrder S; S.init(M, NUP, G, (int)blockIdx.x);
            pg8::EpiUp E{Gb, ss_in};
            pg8::gemm_phase<pg8::EpiUp, pg8::StaticOrder, true, true>(lds, g, S, E);
            GRID_BAR();
        }
#endif
#ifndef NO_DN
        if (IN(pb + 1)) for (int rep_ = 0; rep_ < REP_DN; ++rep_) { asm volatile("; MARK_DN");
            pg8::Gemm g{Gb, (const bf16_t*)(wl + (second ? W_DN2 : W_DN1)), M, DM, DFF}; pg8::StaticOrder S; S.init(M, DM, G, (int)blockIdx.x);
            pg8::EpiRes E{rep_ ? (bf16_t*)(ws + WS_END + 129 * MiB) : HB, rep_ ? (pg8::ss_t*)(ws + WS_END) : ss_out, ((ALPHA_MASK >> (3 * l + 2 * second)) & 1) ? 0.5f : 0.f};
            pg8::gemm_phase<pg8::EpiRes, pg8::StaticOrder, true, true>(lds, g, S, E);
            GRID_BAR();
        }
#endif
        if (!second) {
            pg8::ss_t* sskv = ss + (size_t)(13 + l) * M;
#ifndef NO_IN
            if (IN(pb + 2)) for (int rep_ = 0; rep_ < REP_IN; ++rep_) { asm volatile("; MARK_IN");
                pg8::Gemm g{HB, (const bf16_t*)(wl + W_IN), M, NIN, DM}; pg8::StaticOrder S; S.init(M, NIN, G, (int)blockIdx.x);
                pg8::EpiIn E{ss_out, rep_ == 0 ? sskv : (pg8::ss_t*)(ws + WS_END), cM, lbt + l * 512, QB, KB, CKV, RQ, HLF};
                pg8::gemm_phase<pg8::EpiIn, pg8::StaticOrder, true, true>(lds, g, S, E);
                GRID_BAR();
            }
#endif
#ifndef NO_KVB
            if (IN(pb + 3)) for (int rep_ = 0; rep_ < REP_KVB; ++rep_) { asm volatile("; MARK_KVB");
                pg8::Gemm g{CKV, (const bf16_t*)(wl + W_KVB), M, 2048, KVR}; pg8::StaticOrder S; S.init(M, 2048, G, (int)blockIdx.x);
                pg8::EpiKvb E{sskv, KB, VB};
                pg8::gemm_phase<pg8::EpiKvb, pg8::StaticOrder, true, true>(lds, g, S, E);
                GRID_BAR();
            }
#endif
            if (IN(pb + 4)) for (int rep_ = 0; rep_ < REP_MIX; ++rep_) { asm volatile("; MARK_MIX"); LAUNDER_TID();
#if defined(NO_SCAN) || defined(NO_ATT)
                { const int gt = blockIdx.x * 512 + tid, NT_ = G * 512;
#ifdef NO_ATT
                  for (int i = gt; i < M * 128; i += NT_) { const int row = i >> 7, c = i & 127; *(u32x4*)(CAT + (size_t)row * DM + c * 8) = (u32x4){0u, 0u, 0u, 0u}; }
#endif
#ifdef NO_SCAN
                  for (int i = gt; i < M * 128; i += NT_) { const int row = i >> 7, c = i & 127; *(u32x4*)(CAT + (size_t)row * DM + 1024 + c * 8) = (u32x4){0u, 0u, 0u, 0u}; }
#endif
                }
#endif
#ifndef NO_SCAN
                for (int it = blockIdx.x; it < 64; it += G) { const int type = it >> 5, bh = it & 31;
                    scan::scan_item(lds, type, bh >> 2, bh & 3, type ? HQ : RQ, type ? HK : RK, type ? HV : RV, type ? HG : RG, HLF, (type ? args.in[12] : args.in[10]) + l * 512, CAT, type ? 1536 : 1024); }
#endif
#ifndef NO_ATT
                asm volatile("; MARK_ATT");
                gu32* qh = ctl + CW_QHEAD + 64 * l + 16 * rep_;
                for (;;) {
                    if (tid == 0) MISC[16] = __hip_atomic_fetch_add(qh, 1u, RLX_AGENT);
                    __syncthreads();
                    const int it = __builtin_amdgcn_readfirstlane((int)MISC[16]);
                    __syncthreads();
                    if (it >= 512) break;
                    const int bh = it & 63;
                    att::attn_unit(lds, QB, KB, VB, CAT, args.in[9] + l * 1024, bh >> 3, bh & 7, 7 - (it >> 6));
                }
#endif
                GRID_BAR();
            }
#ifndef NO_OP
            if (IN(pb + 5)) for (int rep_ = 0; rep_ < REP_OP; ++rep_) { asm volatile("; MARK_OP");
                pg8::Gemm g{CAT, (const bf16_t*)(wl + W_O), M, DM, DM}; pg8::StaticOrder S; S.init(M, DM, G, (int)blockIdx.x);
                pg8::EpiRes E{rep_ ? (bf16_t*)(ws + WS_END + 129 * MiB) : HB, rep_ ? (pg8::ss_t*)(ws + WS_END) : ss + (size_t)(3 * l + 2) * M, ((ALPHA_MASK >> (3 * l + 1)) & 1) ? 1.0f : 0.f};
                pg8::gemm_phase<pg8::EpiRes, pg8::StaticOrder, true, true>(lds, g, S, E);
                GRID_BAR();
            }
#endif
        }
    }
    if (IN(49)) { asm volatile("; MARK_FIN"); LAUNDER_TID();
        const pg8::ss_t* ssf = ss + (size_t)12 * M; const f32x4* w4 = (const f32x4*)args.in[18] + lane;
        for (int m = gw; m < M; m += NGW) { const float rs = __builtin_amdgcn_rsqf(pg8::ss_get(ssf + m) * (1.f / DM) + EPS); f32x4* o = (f32x4*)(out + (size_t)m * DM) + lane;
            const u32x2* h2 = (const u32x2*)(HB + (size_t)m * DM) + lane;
#pragma unroll
            for (int j = 0; j < 8; ++j) { const u32x2 hv = h2[64 * j]; const f32x4 hf = {bflo(hv.x), bfhi(hv.x), bflo(hv.y), bfhi(hv.y)}; o[64 * j] = hf * rs * w4[64 * j]; } }
    }
#undef IN
#undef GRID_BAR
}


#ifdef MK_CHECK
constexpr int CW_CHK = 12288;
__device__ __forceinline__ float bf2f(bf16_t v) { return __builtin_bit_cast(float, (unsigned)v << 16); }
__device__ __forceinline__ float rbf(float f) { unsigned u = __builtin_bit_cast(unsigned, f); u = (u + 0x7fffu + ((u >> 16) & 1u)) & 0xffff0000u; return __builtin_bit_cast(float, u); }
__device__ __forceinline__ unsigned hsh(unsigned x) { x ^= x >> 16; x *= 0x7feb352du; x ^= x >> 15; x *= 0x846ca68bu; x ^= x >> 16; return x; }
__device__ __forceinline__ void chk_cmp(unsigned* chk, int id, float got, float want, float rtol = 0.03f, float atol = 0.02f) {
    const float d = fabsf(got - want); if (!(d <= atol + rtol * fabsf(want))) atomicAdd(chk + id, 1u); }

__global__ void chk_prologue(Args a) {
    unsigned* chk = (unsigned*)(a.ws + WS_CTL) + CW_CHK; const unsigned i = blockIdx.x * blockDim.x + threadIdx.x; const unsigned h1 = hsh(i * 2 + 1), h2 = hsh(i * 2 + 2);
    unsigned char* wl = a.ws + WS_W;
    { const int k = h1 % DM, j = h2 % DFF; const float g = a.in[1][k];
      chk_cmp(chk, 0, bf2f(((bf16_t*)(wl + W_UP1))[(size_t)(256 * (j >> 7) + (j & 127)) * DM + k]), a.in[2][(size_t)k * DFF + j] * g, 0.01f, 1e-4f);
      chk_cmp(chk, 1, bf2f(((bf16_t*)(wl + W_UP1))[(size_t)(256 * (j >> 7) + (j & 127) + 128) * DM + k]), a.in[3][(size_t)k * DFF + j] * g, 0.01f, 1e-4f);
      chk_cmp(chk, 2, bf2f(((bf16_t*)(wl + W_DN1))[(size_t)k * DFF + j]), a.in[4][(size_t)j * DM + k], 0.01f, 1e-4f); }
    { const int k = h1 % DM, s = h2 % DIN; chk_cmp(chk, 3, bf2f(((bf16_t*)(wl + W_IN))[(size_t)map_in(s) * DM + k]), a.in[6][(size_t)k * DIN + s] * a.in[5][k], 0.01f, 1e-4f);
      const int zr = 2112 + (h2 % 192); chk_cmp(chk, 3, bf2f(((bf16_t*)(wl + W_IN))[(size_t)zr * DM + k]), 0.f, 0.f, 0.f); }
    { const int k = h1 % KVR, n = h2 % 2048; chk_cmp(chk, 4, bf2f(((bf16_t*)(wl + W_KVB))[(size_t)n * KVR + k]), a.in[8][(size_t)k * 2048 + n] * a.in[7][k], 0.01f, 1e-4f); }
    { const int k = h1 % DM, n = h2 % DM; chk_cmp(chk, 5, bf2f(((bf16_t*)(wl + W_O))[(size_t)n * DM + k]), a.in[13][(size_t)k * DM + n], 0.01f, 1e-4f); }
    { const int t = h1 % SEQ, f = h2 % 32; const float ang = (float)t * powf(10000.f, -(float)(2 * f) / 64.f);
      chk_cmp(chk, 6, ((const float*)(a.ws + WS_TAB + TAB_CM))[t * 32 + f], cosf(ang), 0.f, 2e-3f); chk_cmp(chk, 6, ((const float*)(a.ws + WS_TAB + TAB_SM))[t * 32 + f], sinf(ang), 0.f, 2e-3f); }
    { const int t = h1 % SEQ, f = h2 % 64; const float ang = (float)t * powf(10000.f, -(float)(2 * f) / 128.f);
      chk_cmp(chk, 7, ((const float*)(a.ws + WS_TAB + TAB_CR))[t * 64 + f], cosf(ang), 0.f, 2e-3f); chk_cmp(chk, 7, ((const float*)(a.ws + WS_TAB + TAB_SR))[t * 64 + f], sinf(ang), 0.f, 2e-3f); }
    { const int c = h1 % 512; const float* lg = a.in[11]; float e[4], s = 0.f;
#pragma unroll
      for (int l = 0; l < 4; ++l) { e[l] = expf(lg[l * 512 + c]); s += e[l]; }
      const float* lb = (const float*)(a.ws + WS_TAB + TAB_LB); chk_cmp(chk, 8, lb[c], 0.f, 0.f, 1e-6f); chk_cmp(chk, 8, lb[512 + c], e[1] / s, 0.001f, 1e-6f); chk_cmp(chk, 8, lb[1536 + c], (e[1] + e[2] + e[3]) / s, 0.001f, 1e-6f); }
    { const int m = h1 % M, c = h2 % DM; chk_cmp(chk, 9, bf2f(((bf16_t*)(a.ws + WS_HB))[(size_t)m * DM + c]), a.in[0][(size_t)m * DM + c], 0.01f, 1e-4f);
      if (i < 64) { float s = 0.f; for (int k = 0; k < DM; ++k) { const float v = a.in[0][(size_t)m * DM + k]; s += v * v; } chk_cmp(chk, 9, pg8::ss_get((const pg8::ss_t*)(a.ws + WS_SS) + m), s, 0.001f, 1e-3f); } }
}
__device__ __forceinline__ float dotbf(const bf16_t* A, size_t arow, const bf16_t* Bt, size_t brow, int K) { float s = 0.f; for (int k = 0; k < K; ++k) s += bf2f(A[arow * K + k]) * bf2f(Bt[brow * K + k]); return s; }
__global__ void chk_up(Args a, int hl) {
    unsigned* chk = (unsigned*)(a.ws + WS_CTL) + CW_CHK; const unsigned i = blockIdx.x * blockDim.x + threadIdx.x; const int m = hsh(i * 2 + 1) % M, j = hsh(i * 2 + 2) % DFF;
    const int l = hl >> 1, second = hl & 1; const bf16_t* HB = (const bf16_t*)(a.ws + WS_HB); const bf16_t* W = (const bf16_t*)(a.ws + WS_W + (size_t)l * W_LAYER + (second ? W_UP2 : W_UP1));
    const pg8::ss_t* ss = (const pg8::ss_t*)(a.ws + WS_SS) + (size_t)(3 * l + (second ? 2 : 0)) * M; const float rs = 1.f / sqrtf(pg8::ss_get(ss + m) / DM + EPS);
    const float g = rs * dotbf(HB, m, W, 256 * (j >> 7) + (j & 127), DM), u = rs * dotbf(HB, m, W, 256 * (j >> 7) + (j & 127) + 128, DM);
    chk_cmp(chk, 10, bf2f(((const bf16_t*)(a.ws + WS_ACT))[(size_t)m * DFF + j]), g / (1.f + expf(-g)) * u);
}
__global__ void chk_dn(Args a, int hl, const float* hprev  ) {
    unsigned* chk = (unsigned*)(a.ws + WS_CTL) + CW_CHK; const unsigned i = blockIdx.x * blockDim.x + threadIdx.x; const int m = hsh(i * 2 + 1) % M, c = hsh(i * 2 + 2) % DM;
    const int l = hl >> 1, second = hl & 1; const bf16_t* G = (const bf16_t*)(a.ws + WS_ACT); const bf16_t* W = (const bf16_t*)(a.ws + WS_W + (size_t)l * W_LAYER + (second ? W_DN2 : W_DN1));
    const float want = hprev[(size_t)m * DM + c] + 0.5f * dotbf(G, m, W, c, DFF);
    chk_cmp(chk, 11, a.out[(size_t)m * DM + c], want); chk_cmp(chk, 12, bf2f(((const bf16_t*)(a.ws + WS_HB))[(size_t)m * DM + c]), a.out[(size_t)m * DM + c], 0.01f, 1e-3f);
    if (i < 64) { float s = 0.f; for (int k = 0; k < DM; ++k) { const float v = a.out[(size_t)m * DM + k]; s += v * v; }
        chk_cmp(chk, 13, pg8::ss_get((const pg8::ss_t*)(a.ws + WS_SS) + (size_t)(3 * l + (second ? 3 : 1)) * M + m), s, 0.002f, 1e-2f); }
}
__global__ void chk_in(Args a, int l) {
    unsigned* chk = (unsigned*)(a.ws + WS_CTL) + CW_CHK; const unsigned i = blockIdx.x * blockDim.x + threadIdx.x; const int m = hsh(i * 2 + 1) % M, t = m & (SEQ - 1); const unsigned hh = hsh(i * 2 + 2);
    const bf16_t* HB = (const bf16_t*)(a.ws + WS_HB); const float* W = a.in[6] + (size_t)l * DM * DIN; const float* g = a.in[5] + l * DM;
    const pg8::ss_t* ss = (const pg8::ss_t*)(a.ws + WS_SS) + (size_t)(3 * l + 1) * M; const float rs = 1.f / sqrtf(pg8::ss_get(ss + m) / DM + EPS);
    unsigned char* act = a.ws + WS_ACT;
    auto proj = [&](int s) { float acc = 0.f; for (int k = 0; k < DM; ++k) acc += bf2f(HB[(size_t)m * DM + k]) * rbf(W[(size_t)k * DIN + s] * g[k]); return acc * rs; };
    const int sel = i % 12;
    if (sel == 0) { const int hd = hh % 8, d = (hh >> 8) % 128; chk_cmp(chk, 14, bf2f(((bf16_t*)(act + A_QB))[(size_t)m * 1536 + hd * 192 + d]), proj(hd * 192 + d) * QSCALE); }
    else if (sel == 1) { const int hd = hh % 8, f = (hh >> 8) % 32; const float x1 = proj(hd * 192 + 128 + f), x2 = proj(hd * 192 + 160 + f), ang = (float)t * powf(10000.f, -(float)(2 * f) / 64.f), c = cosf(ang), s = sinf(ang);
        chk_cmp(chk, 15, bf2f(((bf16_t*)(act + A_QB))[(size_t)m * 1536 + hd * 192 + 128 + 2 * f]), (x1 * c - x2 * s) * QSCALE); chk_cmp(chk, 15, bf2f(((bf16_t*)(act + A_QB))[(size_t)m * 1536 + hd * 192 + 128 + 2 * f + 1]), (x2 * c + x1 * s) * QSCALE); }
    else if (sel == 2) { const int c = hh % 512; chk_cmp(chk, 16, bf2f(((bf16_t*)(act + A_CKV))[(size_t)m * KVR + c]), proj(1536 + c));
        if (i < 48) { float s = 0.f; for (int k = 0; k < KVR; ++k) { const float v = bf2f(((bf16_t*)(act + A_CKV))[(size_t)m * KVR + k]); s += v * v; } chk_cmp(chk, 17, pg8::ss_get((const pg8::ss_t*)(a.ws + WS_SS) + (size_t)(13 + l) * M + m), s, 0.02f, 1e-2f); } }
    else if (sel == 3) { const int hd = hh % 8, f = (hh >> 8) % 32; const float x1 = proj(2048 + f), x2 = proj(2080 + f), ang = (float)t * powf(10000.f, -(float)(2 * f) / 64.f), c = cosf(ang), s = sinf(ang);
        chk_cmp(chk, 18, bf2f(((bf16_t*)(act + A_KB))[(size_t)m * 1536 + hd * 192 + 128 + 2 * f]), x1 * c - x2 * s); chk_cmp(chk, 18, bf2f(((bf16_t*)(act + A_KB))[(size_t)m * 1536 + hd * 192 + 128 + 2 * f + 1]), x2 * c + x1 * s); }
    else if (sel == 4 || sel == 5) { const int isk = sel == 5, hd = hh % 4, f = (hh >> 8) % 64, base = isk ? 2624 : 2112; const float sc = isk ? RKSCALE : 1.f;
        const float x1 = proj(base + hd * 128 + f), x2 = proj(base + hd * 128 + 64 + f), ang = (float)t * powf(10000.f, -(float)(2 * f) / 128.f), c = cosf(ang), s = sinf(ang);
        const bf16_t* B = (const bf16_t*)(act + (isk ? A_RK : A_RQ));
        chk_cmp(chk, 19 + isk, bf2f(B[(size_t)m * 512 + hd * 128 + 2 * f]), (x1 * c - x2 * s) * sc); chk_cmp(chk, 19 + isk, bf2f(B[(size_t)m * 512 + hd * 128 + 2 * f + 1]), (x2 * c + x1 * s) * sc); }
    else if (sel == 6) { const int c = hh % 512; chk_cmp(chk, 21, bf2f(((bf16_t*)(act + A_RV))[(size_t)m * 512 + c]), proj(3136 + c)); }
    else if (sel == 7) { const int c = hh % 512; const float v = proj(3648 + c); chk_cmp(chk, 22, bf2f(((bf16_t*)(act + A_RG))[(size_t)m * 512 + c]), v / (1.f + expf(-v))); }
    else if (sel == 8) { const int c = hh % 512; chk_cmp(chk, 23, bf2f(((bf16_t*)(act + A_HQ))[(size_t)m * 512 + c]), proj(4160 + c)); }
    else if (sel == 9) { const int c = hh % 512; const float z = proj(4672 + c), lbv = ((const float*)(a.ws + WS_TAB + TAB_LB))[l * 512 + c], sig = 1.f / (1.f + expf(-z)), f = lbv + (1.f - lbv) * sig;
        chk_cmp(chk, 24, ((const float*)(act + A_HLF))[(size_t)m * 512 + c], logf(fmaxf(f, 1e-20f)), 0.03f, 0.01f); chk_cmp(chk, 25, bf2f(((bf16_t*)(act + A_HK))[(size_t)m * 512 + c]), (1.f - lbv) * (1.f - sig), 0.03f, 0.01f); }
    else if (sel == 10) { const int c = hh % 512; chk_cmp(chk, 26, bf2f(((bf16_t*)(act + A_HV))[(size_t)m * 512 + c]), proj(5184 + c)); }
    else { const int c = hh % 512; const float v = proj(5696 + c); chk_cmp(chk, 27, bf2f(((bf16_t*)(act + A_HG))[(size_t)m * 512 + c]), v / (1.f + expf(-v))); }
}
__global__ void chk_kvb(Args a, int l) {
    unsigned* chk = (unsigned*)(a.ws + WS_CTL) + CW_CHK; const unsigned i = blockIdx.x * blockDim.x + threadIdx.x; const int m = hsh(i * 2 + 1) % M; const unsigned hh = hsh(i * 2 + 2); const int hd = hh % 8, d = (hh >> 8) % 128;
    unsigned char* act = a.ws + WS_ACT; const bf16_t* C = (const bf16_t*)(act + A_CKV); const bf16_t* W = (const bf16_t*)(a.ws + WS_W + (size_t)l * W_LAYER + W_KVB);
    const float rs2 = 1.f / sqrtf(pg8::ss_get((const pg8::ss_t*)(a.ws + WS_SS) + (size_t)(13 + l) * M + m) / KVR + EPS);
    chk_cmp(chk, 28, bf2f(((bf16_t*)(act + A_KB))[(size_t)m * 1536 + hd * 192 + d]), rs2 * dotbf(C, m, W, hd * 256 + d, KVR));
    chk_cmp(chk, 29, bf2f(((bf16_t*)(act + A_VB))[(size_t)m * 1024 + hd * 128 + d]), rs2 * dotbf(C, m, W, hd * 256 + 128 + d, KVR));
}
__global__ void chk_attn(Args a, int l) {
    unsigned* chk = (unsigned*)(a.ws + WS_CTL) + CW_CHK; __shared__ float red[128];
    const unsigned hh = hsh(blockIdx.x * 7 + 3); const int b = hh % 8, h = (hh >> 3) % 8; int t = (hh >> 8) % SEQ; if (blockIdx.x < 8) t = (blockIdx.x & 1) ? 255 + 256 * (blockIdx.x >> 1) : 256 * (blockIdx.x >> 1);
    const int e = threadIdx.x; unsigned char* act = a.ws + WS_ACT; const bf16_t* Q = (const bf16_t*)(act + A_QB) + ((size_t)(b * SEQ + t) * 1536 + h * 192);
    const bf16_t* K = (const bf16_t*)(act + A_KB) + (size_t)b * SEQ * 1536 + h * 192; const bf16_t* V = (const bf16_t*)(act + A_VB) + (size_t)b * SEQ * 1024 + h * 128 + e;
    float mx = -1e30f; for (int j = 0; j <= t; ++j) { float s = 0.f; for (int d = 0; d < 192; ++d) s += bf2f(Q[d]) * bf2f(K[(size_t)j * 1536 + d]); mx = fmaxf(mx, s); }
    float den = 0.f, num = 0.f; for (int j = 0; j <= t; ++j) { float s = 0.f; for (int d = 0; d < 192; ++d) s += bf2f(Q[d]) * bf2f(K[(size_t)j * 1536 + d]); const float p = exp2f(s - mx); den += p; num += p * bf2f(V[(size_t)j * 1024]); }
    const float o = num / den; red[e] = o * o; __syncthreads(); for (int s = 64; s > 0; s >>= 1) { if (e < s) red[e] += red[e + s]; __syncthreads(); }
    const float want = o / sqrtf(red[0] / 128.f + EPS) * a.in[9][l * 1024 + h * 128 + e];
    chk_cmp(chk, 30, bf2f(((bf16_t*)(act + A_CAT))[(size_t)(b * SEQ + t) * DM + h * 128 + e]), want, 0.1f, 0.1f);
}
__global__ void __launch_bounds__(512) chk_scan(Args a, int l) {
    unsigned* chk = (unsigned*)(a.ws + WS_CTL) + CW_CHK; __shared__ float red[4][128]; __shared__ float ov[128]; constexpr int NTOK = 200;
    const int type = blockIdx.x & 1, b = (blockIdx.x >> 1) % 8, h = (blockIdx.x * 5 + 1) % 4, e = threadIdx.x & 127, dg = threadIdx.x >> 7; unsigned char* act = a.ws + WS_ACT;
    const bf16_t* Qg = (const bf16_t*)(act + (type ? A_HQ : A_RQ)); const bf16_t* Kg = (const bf16_t*)(act + (type ? A_HK : A_RK)); const bf16_t* Vg = (const bf16_t*)(act + (type ? A_HV : A_RV));
    const bf16_t* Gg = (const bf16_t*)(act + (type ? A_HG : A_RG)); const float* LF = (const float*)(act + A_HLF); const float* nw = (type ? a.in[12] : a.in[10]) + l * 512;
    const float gam = 1.f - 1.f / (float)(32 << h);
    float S[32];
#pragma unroll
    for (int d = 0; d < 32; ++d) S[d] = 0.f;
    for (int t = 0; t < NTOK; ++t) { const size_t ro = ((size_t)(b * SEQ + t)) * 512 + h * 128; const float v = bf2f(Vg[ro + e]); float o = 0.f;
#pragma unroll
        for (int d = 0; d < 32; ++d) { const int dd = 32 * dg + d; const float f = type ? __expf(LF[ro + dd]) : gam; S[d] = f * S[d] + bf2f(Kg[ro + dd]) * v; o += bf2f(Qg[ro + dd]) * S[d]; }
        red[dg][e] = o; __syncthreads(); o = red[0][e] + red[1][e] + red[2][e] + red[3][e]; if (dg == 0) ov[e] = o; __syncthreads();
        float s1 = 0.f; for (int d = 0; d < 128; ++d) s1 += ov[d]; const float mu = type ? 0.f : s1 / 128.f;
        float s2 = 0.f; for (int d = 0; d < 128; ++d) s2 += (ov[d] - mu) * (ov[d] - mu);
        const float want = (o - mu) / sqrtf(s2 / 128.f + EPS) * nw[h * 128 + e] * bf2f(Gg[ro + e]);
        if (dg == 0) chk_cmp(chk, 31 + type, bf2f(((bf16_t*)(act + A_CAT))[(size_t)(b * SEQ + t) * DM + 1024 + type * 512 + h * 128 + e]), want, 0.1f, 0.1f);
        __syncthreads(); }
}
__global__ void chk_op(Args a, int l, const float* hprev) {
    unsigned* chk = (unsigned*)(a.ws + WS_CTL) + CW_CHK; const unsigned i = blockIdx.x * blockDim.x + threadIdx.x; const int m = hsh(i * 2 + 1) % M, c = hsh(i * 2 + 2) % DM;
    const float want = hprev[(size_t)m * DM + c] + dotbf((const bf16_t*)(a.ws + WS_ACT + A_CAT), m, (const bf16_t*)(a.ws + WS_W + (size_t)l * W_LAYER + W_O), c, DM);
    chk_cmp(chk, 33, a.out[(size_t)m * DM + c], want);
}
__global__ void chk_report(Args a) {
    const unsigned* chk = (const unsigned*)(a.ws + WS_CTL) + CW_CHK; int first = -1; for (int i = 0; i < 64; ++i) if (chk[i] && first < 0) first = i;
    if (first < 0) return; const float c = sqrtf(0.1f * (float)(first + 1));
    for (size_t i = blockIdx.x * (size_t)blockDim.x + threadIdx.x; i < (size_t)M * DM; i += (size_t)gridDim.x * blockDim.x) a.out[i] = c;
}
#endif
extern "C" void kernel_launch(void* const* d_in, const int* in_sizes, int n_in, void* d_out, int out_size, void* d_ws, size_t ws_size, hipStream_t stream) {
    static int grid = 0;
    if (grid == 0) {
        if (n_in != 19 || in_sizes[0] != M * DM || out_size != M * DM || ws_size < WS_END) {
            fprintf(stderr, "kernel_launch: built for 19 inputs, x and out of %d floats, >= %zu bytes of workspace; got n_in %d, in0 %d, out %d, ws %zu; nothing launched\n", M * DM, (size_t)WS_END, n_in, n_in > 0 ? in_sizes[0] : -1, out_size, ws_size);
            grid = -1; return; }
        int dev = 0, cus = 0, per_cu = 0;
        if (hipGetDevice(&dev) != hipSuccess || hipDeviceGetAttribute(&cus, hipDeviceAttributeMultiprocessorCount, dev) != hipSuccess) { fprintf(stderr, "kernel_launch: device query failed\n"); grid = -1; return; }
        if (hipFuncSetAttribute((const void*)mk_fwd, hipFuncAttributeMaxDynamicSharedMemorySize, LDS_BYTES) != hipSuccess) { fprintf(stderr, "kernel_launch: hipFuncSetAttribute failed\n"); grid = -1; return; }
        if (hipOccupancyMaxActiveBlocksPerMultiprocessor(&per_cu, (const void*)mk_fwd, 512, LDS_BYTES) != hipSuccess || per_cu < 1) {
            fprintf(stderr, "kernel_launch: occupancy query reports %d workgroups per CU\n", per_cu); (void)hipGetLastError(); per_cu = 1; }
        grid = cus;
    }
    if (grid < 0) return;
    if (hipMemsetAsync((char*)d_ws + WS_CTL, 0, CTL_ZERO_BYTES, stream) != hipSuccess) { fprintf(stderr, "kernel_launch: memset failed\n"); return; }
    Args a{};
    for (int i = 0; i < 19; ++i) a.in[i] = (const float*)d_in[i];
    a.out = (float*)d_out; a.ws = (unsigned char*)d_ws;
#if MK_ONE_LAUNCH
    a.ph_lo = 0; a.ph_hi = NPH;
    hipLaunchKernelGGL(mk_fwd, dim3(grid), dim3(512), LDS_BYTES, stream, a);
    { const hipError_t le = hipPeekAtLastError(); if (le != hipSuccess) fprintf(stderr, "kernel_launch: launch failed: %s\n", hipGetErrorName(le)); }
#else
    for (int ph = 0; ph < NPH; ++ph) {
        if (ph >= 1 && ph < 49) { const int hl = (ph - 1) / 6, p = (ph - 1) % 6; if ((hl & 1) && p >= 2) continue; }
        a.ph_lo = ph; a.ph_hi = ph + 1;
#ifdef MK_CHECK
        float* hprev = (float*)((unsigned char*)d_ws + WS_END);
        if (ph == 6) (void)hipMemcpyAsync(hprev, d_out, (size_t)M * DM * 4, hipMemcpyDeviceToDevice, stream);
#endif
        hipLaunchKernelGGL(mk_fwd, dim3(grid), dim3(512), LDS_BYTES, stream, a);
        const hipError_t le = hipPeekAtLastError(); if (le != hipSuccess) { fprintf(stderr, "kernel_launch: launch of phase %d failed: %s\n", ph, hipGetErrorName(le)); break; }
#ifdef MK_CHECK
        if (ph == 0) hipLaunchKernelGGL(chk_prologue, dim3(64), dim3(256), 0, stream, a);
        if (ph == 1) hipLaunchKernelGGL(chk_up, dim3(4), dim3(256), 0, stream, a, 0);
        if (ph == 2) hipLaunchKernelGGL(chk_dn, dim3(4), dim3(256), 0, stream, a, 0, (const float*)d_in[0]);
        if (ph == 3) hipLaunchKernelGGL(chk_in, dim3(8), dim3(256), 0, stream, a, 0);
        if (ph == 4) hipLaunchKernelGGL(chk_kvb, dim3(4), dim3(256), 0, stream, a, 0);
        if (ph == 5) { hipLaunchKernelGGL(chk_attn, dim3(24), dim3(128), 0, stream, a, 0); hipLaunchKernelGGL(chk_scan, dim3(8), dim3(512), 0, stream, a, 0); }
        if (ph == 6) hipLaunchKernelGGL(chk_op, dim3(4), dim3(256), 0, stream, a, 0, (const float*)hprev);
        if (ph == NPH - 1) hipLaunchKernelGGL(chk_report, dim3(1024), dim3(256), 0, stream, a);
#endif
    }
#endif
}
```
